# Optimizing an MI355X kernel written in HIP

```python
import math
import jax, jax.numpy as jnp
from jax import lax
import numpy as np

D_MODEL = 2048
BATCH = 4
SEQ = 2048
DEPTH = 2

GRID_W = 64
CTX_LEN = 256
HEAD_DIM = 64
N_BRANCH = 4
BRANCH_W = D_MODEL // N_BRANCH
A_HEADS = BRANCH_W // HEAD_DIM
A_KV_HEADS = A_HEADS // 4
A_WINDOW = 128
A_BLOCK = 128
B_HEADS = BRANCH_W // HEAD_DIM
B_WIN_ROWS_MAX = 8
B_WIN_COLS = 16
B_QCOLS = 16
B_KCOLS = 32
C_WINDOWS = (2, 4, 8, 16)
C_GROUPS = len(C_WINDOWS)
C_GROUP_DIM = BRANCH_W // C_GROUPS
D_HEADS = BRANCH_W // (2 * HEAD_DIM)
D_BLOCK = 128
D_FF = 4 * D_MODEL
ROPE_BASE = 10000.0
EPS = 1e-6
NEG = -1e30

A_W = A_HEADS * HEAD_DIM
A_KV_W = A_KV_HEADS * HEAD_DIM
B_W = B_HEADS * HEAD_DIM
C_W = C_GROUPS * C_GROUP_DIM
D_W = D_HEADS * 2 * HEAD_DIM
SPLIT_SIZES = (A_W, A_KV_W, A_KV_W, B_W, B_W, B_W, C_W, D_W, D_W, D_W, N_BRANCH * D_MODEL)
SPLIT_POINTS = tuple(int(v) for v in np.cumsum(SPLIT_SIZES)[:-1])
PROJ_W = int(sum(SPLIT_SIZES))

kernel_name = "hybrid_gated_parallel_mixers_dit"

F32 = jnp.float32


def rms_norm(x, g):
    xf = x.astype(F32)
    y = xf * lax.rsqrt(jnp.mean(xf * xf, axis=-1, keepdims=True) + EPS)
    return (y * g.astype(F32)).astype(x.dtype)


def modulate(h, shift, scale):
    return h * (1 + scale) + shift


def axial_rope(n):
    t = jnp.arange(n)
    row = (t // GRID_W).astype(F32)
    col = (t % GRID_W).astype(F32)
    n_freq = HEAD_DIM // 4
    inv = ROPE_BASE ** (-jnp.arange(n_freq, dtype=F32) / n_freq)
    ang = jnp.concatenate([row[:, None] * inv, col[:, None] * inv], axis=-1)
    return jnp.cos(ang), jnp.sin(ang)


def rope2d(x, cos, sin):
    q = HEAD_DIM // 4
    xf = x.astype(F32)
    x1 = jnp.concatenate([xf[..., :q], xf[..., 2 * q:3 * q]], axis=-1)
    x2 = jnp.concatenate([xf[..., q:2 * q], xf[..., 3 * q:]], axis=-1)
    c = cos[:, None, :]
    s = sin[:, None, :]
    y1 = x1 * c - x2 * s
    y2 = x2 * c + x1 * s
    return jnp.concatenate([y1[..., :q], y2[..., :q], y1[..., q:], y2[..., q:]], axis=-1).astype(x.dtype)


def split_heads(z, qk_g, rope=None):
    B_, n, _ = z.shape
    aq, ak, av, bq, bk, bv, cu, dq, dk, dv, gz = jnp.split(z, SPLIT_POINTS, axis=-1)
    aq = rms_norm(aq.reshape(B_, n, A_HEADS, HEAD_DIM), qk_g[0, 0])
    ak = rms_norm(ak.reshape(B_, n, A_KV_HEADS, HEAD_DIM), qk_g[0, 1])
    bq = rms_norm(bq.reshape(B_, n, B_HEADS, HEAD_DIM), qk_g[1, 0])
    bk = rms_norm(bk.reshape(B_, n, B_HEADS, HEAD_DIM), qk_g[1, 1])
    dq = rms_norm(dq.reshape(B_, n, 2 * D_HEADS, HEAD_DIM), qk_g[2, 0])
    dk = rms_norm(dk.reshape(B_, n, 2 * D_HEADS, HEAD_DIM), qk_g[2, 1])
    if rope is not None:
        cos, sin = rope
        aq = rope2d(aq, cos, sin)
        ak = rope2d(ak, cos, sin)
        dq = rope2d(dq, cos, sin)
        dk = rope2d(dk, cos, sin)
    av = av.reshape(B_, n, A_KV_HEADS, HEAD_DIM)
    bv = bv.reshape(B_, n, B_HEADS, HEAD_DIM)
    dq = dq.reshape(B_, n, D_HEADS, 2, HEAD_DIM)
    dk = dk.reshape(B_, n, D_HEADS, 2, HEAD_DIM)
    dv = dv.reshape(B_, n, D_HEADS, 2 * HEAD_DIM)
    return (aq, ak, av, bq, bk, bv, cu, dq, dk, dv, gz)


def context_attn(q, k, v, sink=None):
    B_, nq, H, Dh = q.shape
    G = k.shape[2]
    R = H // G
    nk = k.shape[1]
    qg = q.reshape(B_, nq, G, R, Dh)
    s = jnp.einsum('bqgrd,bkgd->bgrqk', qg, k, preferred_element_type=F32) * Dh ** -0.5
    if sink is not None:
        s_sink = jnp.broadcast_to(sink.astype(F32).reshape(G, R)[None, :, :, None, None], s.shape[:-1] + (1,))
        s = jnp.concatenate([s, s_sink], axis=-1)
    p = jax.nn.softmax(s, axis=-1)[..., :nk]
    o = jnp.einsum('bgrqk,bkgd->bqgrd', p.astype(v.dtype), v)
    return o.reshape(B_, nq, H * Dh)


def window_gqa(q, k, v, kc, vc, sink):
    B_, S, _, _ = q.shape
    nb = S // A_BLOCK
    G, R = A_KV_HEADS, A_HEADS // A_KV_HEADS
    nc = kc.shape[1]
    qb = q.reshape(B_, nb, A_BLOCK, G, R, HEAD_DIM)

    def band(t):
        tb = t.reshape(B_, nb, A_BLOCK, G, HEAD_DIM)
        tp = jnp.pad(tb, ((0, 0), (1, 1), (0, 0), (0, 0), (0, 0)))
        return jnp.concatenate([tp[:, :-2], tp[:, 1:-1], tp[:, 2:]], axis=2)

    kb, vb = band(k), band(v)
    scale = HEAD_DIM ** -0.5
    s_lat = jnp.einsum('bnqgrd,bnkgd->bngrqk', qb, kb, preferred_element_type=F32) * scale
    qpos = jnp.arange(S).reshape(nb, A_BLOCK)
    kpos = (jnp.arange(nb)[:, None] - 1) * A_BLOCK + jnp.arange(3 * A_BLOCK)[None, :]
    valid = ((jnp.abs(qpos[:, :, None] - kpos[:, None, :]) <= A_WINDOW)
             & (kpos[:, None, :] >= 0) & (kpos[:, None, :] < S))
    s_lat = jnp.where(valid[None, :, None, None], s_lat, NEG)
    s_ctx = jnp.einsum('bnqgrd,bkgd->bngrqk', qb, kc, preferred_element_type=F32) * scale
    s_sink = jnp.broadcast_to(sink.astype(F32).reshape(G, R)[None, None, :, :, None, None], s_lat.shape[:-1] + (1,))
    p = jax.nn.softmax(jnp.concatenate([s_lat, s_ctx, s_sink], axis=-1), axis=-1).astype(v.dtype)
    L = 3 * A_BLOCK
    o = (jnp.einsum('bngrqk,bnkgd->bnqgrd', p[..., :L], vb)
         + jnp.einsum('bngrqk,bkgd->bnqgrd', p[..., L:L + nc], vc))
    return o.reshape(B_, S, A_W)


def neighbourhood_attn(q, k, v, kc, vc, rpb):
    B_, S, H, Dh = q.shape
    rows = S // GRID_W
    kh = min(B_WIN_ROWS_MAX, rows)
    ncb = GRID_W // B_QCOLS
    nc = kc.shape[1]
    r = jnp.arange(rows)
    rs = jnp.clip(r - kh // 2, 0, rows - kh)
    key_rows = rs[:, None] + jnp.arange(kh)[None, :]
    cs = jnp.clip(jnp.arange(GRID_W) - B_WIN_COLS // 2, 0, GRID_W - B_WIN_COLS)
    kb0 = jnp.clip(jnp.arange(ncb) * B_QCOLS - B_WIN_COLS // 2, 0, GRID_W - B_KCOLS)
    key_cols = kb0[:, None] + jnp.arange(B_KCOLS)[None, :]
    qcol = jnp.arange(ncb)[:, None] * B_QCOLS + jnp.arange(B_QCOLS)[None, :]

    def gather(t):
        tg = t.reshape(B_, rows, GRID_W, H, Dh)
        return tg[:, key_rows[:, :, None, None], key_cols[None, None, :, :]]

    kg, vg = gather(k), gather(v)
    qg = q.reshape(B_, rows, ncb, B_QCOLS, H, Dh)
    scale = Dh ** -0.5
    s = jnp.einsum('brjqhd,brkjchd->bhrjqkc', qg, kg, preferred_element_type=F32) * scale
    cs_q = cs[qcol]
    kcol = key_cols[:, None, :]
    valid = (kcol >= cs_q[:, :, None]) & (kcol < cs_q[:, :, None] + B_WIN_COLS)
    ri = key_rows - r[:, None] + (B_WIN_ROWS_MAX - 1)
    ci = jnp.clip(kcol - qcol[:, :, None] + (B_WIN_COLS - 1), 0, 2 * B_WIN_COLS - 2)
    bias = rpb[:, ri[:, None, None, :, None], ci[None, :, :, None, :]]
    s = s + bias.astype(F32)[None]
    s = jnp.where(valid[None, None, None, :, :, None, :], s, NEG)
    s = s.reshape(B_, H, rows, ncb, B_QCOLS, kh * B_KCOLS)
    s_ctx = jnp.einsum('brjqhd,bkhd->bhrjqk', qg, kc, preferred_element_type=F32) * scale
    p = jax.nn.softmax(jnp.concatenate([s, s_ctx], axis=-1), axis=-1).astype(v.dtype)
    nl = kh * B_KCOLS
    p_lat = p[..., :nl].reshape(B_, H, rows, ncb, B_QCOLS, kh, B_KCOLS)
    o = (jnp.einsum('bhrjqkc,brkjchd->brjqhd', p_lat, vg)
         + jnp.einsum('bhrjqk,bkhd->brjqhd', p[..., nl:nl + nc], vc))
    return o.reshape(B_, S, B_W)


def multiscale_pool(u):
    n = u.shape[1]
    uf = u.astype(F32)
    csum = jnp.pad(jnp.cumsum(uf, axis=1), ((0, 0), (1, 0), (0, 0)))
    t = jnp.arange(n)
    outs = []
    for g, w in enumerate(C_WINDOWS):
        lo = jnp.clip(t - w // 2, 0, n - 1)
        hi = jnp.clip(t + w - 1 - w // 2, 0, n - 1)
        cg = csum[..., g * C_GROUP_DIM:(g + 1) * C_GROUP_DIM]
        cnt = (hi - lo + 1).astype(F32)[None, :, None]
        outs.append((cg[:, hi + 1] - cg[:, lo]) / cnt)
    return (jnp.concatenate(outs, axis=-1) - uf).astype(u.dtype)


def pool_branch(u, w, scale):
    B_, n, _ = u.shape
    pooled = multiscale_pool(u).reshape(B_, n, C_GROUPS, C_GROUP_DIM)
    y = jnp.einsum('bngc,gce->bnge', pooled, w).reshape(B_, n, C_W)
    return y * scale


def diff_core(q, k, v, lam):
    s = jnp.einsum('bqhmd,bkhmd->bhmqk', q, k, preferred_element_type=F32) * HEAD_DIM ** -0.5
    p = jax.nn.softmax(s, axis=-1)
    a = p[:, :, 0] - lam * p[:, :, 1]
    return jnp.einsum('bhqk,bkhe->bqhe', a.astype(v.dtype), v)


def diff_post(o, g, lam_init):
    B_, n = o.shape[:2]
    return (rms_norm(o, g) * (1 - lam_init)).reshape(B_, n, D_W)


def diff_latent(q, k, v, kc, vc, lam):
    B_, S = q.shape[:2]
    nb = S // D_BLOCK
    kall = jnp.concatenate([k, kc], axis=1)
    vall = jnp.concatenate([v, vc], axis=1)
    qb = q.reshape(B_, nb, D_BLOCK, D_HEADS, 2, HEAD_DIM).swapaxes(0, 1)
    o = lax.map(lambda qblk: diff_core(qblk, kall, vall, lam), qb)
    return o.swapaxes(0, 1).reshape(B_, S, D_HEADS, 2 * HEAD_DIM)


def merge_branches(ys, gz, b_gate, w_branch, w_out):
    B_, n, _ = gz.shape
    g = jax.nn.sigmoid((gz + b_gate).astype(F32)).astype(gz.dtype).reshape(B_, n, N_BRANCH, D_MODEL)
    proj = jnp.einsum('bnkw,kwd->bnkd', jnp.stack(ys, axis=2), w_branch)
    return jnp.sum(g * proj, axis=2) @ w_out


def sq_relu_mlp(h, w1, w2):
    return jnp.square(jax.nn.relu(h @ w1)) @ w2


def setup_inputs(seed: int = 0) -> dict:
    key = jax.random.key(seed)
    ks = jax.random.split(key, 24)

    def nrm(k, shape, s):
        return s * jax.random.normal(k, shape, F32)

    return {
        "x": nrm(ks[0], (BATCH, SEQ, D_MODEL), 1.0),
        "c": nrm(ks[1], (BATCH, D_MODEL), 1.0),
        "ctx": nrm(ks[2], (BATCH, CTX_LEN, D_MODEL), 1.0),
        "c_ctx": nrm(ks[3], (D_MODEL,), 1.0),
        "w_ada": nrm(ks[4], (DEPTH, D_MODEL, 6 * D_MODEL), 0.5 * D_MODEL ** -0.5),
        "b_ada": nrm(ks[5], (DEPTH, 6 * D_MODEL), 0.01),
        "g_norm1": 1.0 + nrm(ks[6], (DEPTH, D_MODEL), 0.05),
        "g_norm2": 1.0 + nrm(ks[7], (DEPTH, D_MODEL), 0.05),
        "w_in": nrm(ks[8], (DEPTH, D_MODEL, PROJ_W), D_MODEL ** -0.5),
        "b_gate": nrm(ks[9], (DEPTH, N_BRANCH * D_MODEL), 0.01),
        "qk_gain": 1.0 + nrm(ks[10], (DEPTH, 3, 2, HEAD_DIM), 0.05),
        "a_sink": nrm(ks[11], (DEPTH, A_HEADS), 0.5),
        "b_rpb": nrm(ks[12], (DEPTH, B_HEADS, 2 * B_WIN_ROWS_MAX - 1, 2 * B_WIN_COLS - 1), 0.1),
        "c_w": nrm(ks[13], (DEPTH, C_GROUPS, C_GROUP_DIM, C_GROUP_DIM), C_GROUP_DIM ** -0.5),
        "c_scale": 1.0 + nrm(ks[14], (DEPTH, C_W), 0.1),
        "d_lambda": nrm(ks[15], (DEPTH, 4, HEAD_DIM), 0.1),
        "d_subln": 1.0 + nrm(ks[16], (DEPTH, 2 * HEAD_DIM), 0.05),
        "w_branch": nrm(ks[17], (DEPTH, N_BRANCH, BRANCH_W, D_MODEL), BRANCH_W ** -0.5),
        "w_out": nrm(ks[18], (DEPTH, D_MODEL, D_MODEL), D_MODEL ** -0.5),
        "w_ff1": nrm(ks[19], (DEPTH, D_MODEL, D_FF), D_MODEL ** -0.5),
        "w_ff2": nrm(ks[20], (DEPTH, D_FF, D_MODEL), D_FF ** -0.5),
    }


def reference(x, c, ctx, c_ctx, w_ada, b_ada, g_norm1, g_norm2, w_in, b_gate, qk_gain, a_sink, b_rpb,
              c_w, c_scale, d_lambda, d_subln, w_branch, w_out, w_ff1, w_ff2):
    n = x.shape[1]
    rope = axial_rope(n)
    xc = ctx
    for l in range(DEPTH):
        last = l == DEPTH - 1
        mod = (jax.nn.silu(c) @ w_ada[l] + b_ada[l])[:, None, :]
        mod_c = (jax.nn.silu(c_ctx) @ w_ada[l] + b_ada[l])[None, None, :]
        sh1, sc1, gt1, sh2, sc2, gt2 = jnp.split(mod, 6, axis=-1)
        sh1c, sc1c, gt1c, sh2c, sc2c, gt2c = jnp.split(mod_c, 6, axis=-1)
        lam_init = 0.8 - 0.6 * math.exp(-0.3 * l)
        dl = d_lambda[l].astype(F32)
        lam = jnp.exp(jnp.sum(dl[0] * dl[1])) - jnp.exp(jnp.sum(dl[2] * dl[3])) + lam_init

        h = modulate(rms_norm(x, g_norm1[l]), sh1, sc1)
        hc = modulate(rms_norm(xc, g_norm1[l]), sh1c, sc1c)
        aq, ak, av, bq, bk, bv, cu, dq, dk, dv, gz = split_heads(h @ w_in[l], qk_gain[l], rope)
        aqc, akc, avc, bqc, bkc, bvc, cuc, dqc, dkc, dvc, gzc = split_heads(hc @ w_in[l], qk_gain[l])
        ya = window_gqa(aq, ak, av, akc, avc, a_sink[l])
        yb = neighbourhood_attn(bq, bk, bv, bkc, bvc, b_rpb[l])
        yc = pool_branch(cu, c_w[l], c_scale[l])
        yd = diff_post(diff_latent(dq, dk, dv, dkc, dvc, lam), d_subln[l], lam_init)
        x = x + gt1 * merge_branches([ya, yb, yc, yd], gz, b_gate[l], w_branch[l], w_out[l])
        if not last:
            yac = context_attn(aqc, akc, avc, a_sink[l])
            ybc = context_attn(bqc, bkc, bvc)
            ycc = pool_branch(cuc, c_w[l], c_scale[l])
            ydc = diff_post(diff_core(dqc, dkc, dvc, lam), d_subln[l], lam_init)
            xc = xc + gt1c * merge_branches([yac, ybc, ycc, ydc], gzc, b_gate[l], w_branch[l], w_out[l])

        h2 = modulate(rms_norm(x, g_norm2[l]), sh2, sc2)
        x = x + gt2 * sq_relu_mlp(h2, w_ff1[l], w_ff2[l])
        if not last:
            h2c = modulate(rms_norm(xc, g_norm2[l]), sh2c, sc2c)
            xc = xc + gt2c * sq_relu_mlp(h2c, w_ff1[l], w_ff2[l])
    return x
```

```cpp
#include <hip/hip_runtime.h>
#include <hip/hip_cooperative_groups.h>
#include <cstdio>
#include <cstdint>
namespace cg = cooperative_groups;

#define DI __device__ __forceinline__
#define LAS __attribute__((address_space(3)))
#define GAS __attribute__((address_space(1)))
typedef unsigned short bf16_t;
typedef short bf16x8 __attribute__((ext_vector_type(8)));
typedef float f32x4 __attribute__((ext_vector_type(4)));
typedef float f32x2 __attribute__((ext_vector_type(2)));
typedef unsigned u32x4 __attribute__((ext_vector_type(4)));
typedef unsigned u32x2 __attribute__((ext_vector_type(2)));
typedef __bf16 bf16x2_t __attribute__((ext_vector_type(2)));

#ifndef N_LAUNCH_MODE
#define N_LAUNCH_MODE 1
#endif

constexpr int DM = 2048, NBATCH = 4, SEQ = 2048, CTXL = 256, NLAT = NBATCH * SEQ, NCTX = NBATCH * CTXL, MROWS = NLAT + NCTX;
constexpr int PROJ = 12544, ZW = 4352, GW = 8192, DFF = 8192, MODW = 6 * DM;
constexpr int Z_AQ = 0, Z_AK = 512, Z_AV = 640, Z_BQ = 768, Z_BK = 1280, Z_BV = 1792, Z_CU = 2304, Z_DQ = 2816, Z_DK = 3328, Z_DV = 3840;
constexpr float EPS = 1e-6f, LOG2E = 1.4426950408889634f, QSCALE = 0.125f * LOG2E, NEGBIG = -1e30f;
constexpr int NTHREADS = 512, NWAVES = 8;

constexpr size_t MiB = 1u << 20;
constexpr size_t WS_MISC = 0;
constexpr size_t WS_BAR = 1536 * 1024;
constexpr size_t WS_MOD = 4096;
constexpr size_t WS_ROPE = 512 * 1024;
constexpr size_t WS_CWT = 1 * MiB;
constexpr size_t WS_WT = 2 * MiB;
constexpr size_t WT_IN = 0, WT_BR = (size_t)PROJ * DM, WT_OUT = WT_BR + (size_t)DM * DM, WT_F1 = WT_OUT + (size_t)DM * DM, WT_F2 = WT_F1 + (size_t)DFF * DM, WT_LAYER = WT_F2 + (size_t)DFF * DM;
constexpr size_t WS_XS = 260 * MiB;
constexpr size_t WS_H = 332 * MiB;
constexpr size_t WS_Y = 368 * MiB;
constexpr size_t WS_MB = 404 * MiB;
constexpr size_t WS_Z = 440 * MiB;
constexpr size_t WS_G = 517 * MiB;
constexpr size_t WS_U = 440 * MiB;
constexpr size_t WS_PB = 661 * MiB;
constexpr size_t WS_END = 725 * MiB;
constexpr int KSPLIT = 8;
static_assert(WS_WT + 2 * WT_LAYER * 2 <= WS_XS, "weights fit");
static_assert(WS_Z + (size_t)MROWS * ZW * 2 <= WS_G && WS_G + (size_t)MROWS * GW * 2 <= WS_END && WS_U + (size_t)MROWS * DFF * 2 <= WS_END, "ws map");

constexpr int LDS_BYTES = 131072 + 1024;

DI unsigned pk2(float lo, float hi) { f32x2 v = {lo, hi}; bf16x2_t b = __builtin_convertvector(v, bf16x2_t); return __builtin_bit_cast(unsigned, b); }
DI float bflo(unsigned u) { return __uint_as_float(u << 16); }
DI float bfhi(unsigned u) { return __uint_as_float(u & 0xffff0000u); }
DI float shx(float v, int m, int lane) { return __builtin_bit_cast(float, __builtin_amdgcn_ds_bpermute((lane ^ m) << 2, __builtin_bit_cast(int, v))); }
DI float wave_sum(float v, int lane) {
#pragma unroll
    for (int o = 1; o < 64; o <<= 1) v += shx(v, o, lane);
    return v;
}
DI float fast_exp2(float x) { return __builtin_amdgcn_exp2f(x); }
DI float fast_rcp(float x) { return __builtin_amdgcn_rcpf(x); }

namespace pg8 {
constexpr int BM = 256, BK = 64, HALF = 128, HTB = HALF * BK * 2, STAGE_BYTES = 8 * HTB, NXCD = 8, WGM = 8;
__host__ __device__ __forceinline__ int lds_byte(int r, int c) { const int st = (r >> 4) * 2 + (c >> 5), rr = r & 15, cc = c & 31, ob = rr * 64 + cc * 2; return st * 1024 + (ob ^ (((ob >> 9) & 1) << 5)); }
__host__ __device__ __forceinline__ void stage_rc(int b, int& R, int& C) { const int st = b / 1024, sb = b % 1024, swz = sb ^ (((sb >> 9) & 1) << 5); R = (st >> 1) * 16 + swz / 64; C = (st & 1) * 32 + (swz % 64) / 2; }
__host__ __device__ __forceinline__ int perm32(int rho) { const int n = rho >> 4, i = rho & 15; return 8 * (i >> 2) + 4 * n + (i & 3); }

struct Unit { int pm, pn, ks; };
struct Gemm { const bf16_t* A; const bf16_t* Bt; int M, N, K; int rowsA, rowsB; };

struct StaticOrder {
    int nM, nN, nwg, G, c, nsplit, nM2;
    __device__ void init(int M, int N, int G_, int c_, int M2 = 0, int nsplit_ = 0) { nM = M / BM; nN = N / BM; nwg = nM * nN; G = G_; c = c_; nsplit = nsplit_; nM2 = M2 / BM; }
    __device__ bool next(int i, Unit& u) const {
        const long L = (long)i * G + c;
        if (L >= nwg) { const long j = L - nwg; if (j >= (long)nM2 * nN * nsplit) return false;
            const int jj = (int)j; u.ks = jj % nsplit; const int tl = jj / nsplit; u.pn = tl % nN; u.pm = nM + tl / nN; return true; }
        u.ks = -1;
        int wgid = (int)L; { const int q = nwg / NXCD, r = nwg % NXCD, xcd = wgid % NXCD, off = wgid / NXCD; wgid = (xcd < r ? xcd * (q + 1) : r * (q + 1) + (xcd - r) * q) + off; }
        const int nig = WGM * nN, gid = wgid / nig, fm = gid * WGM, gsz = (nM - fm) < WGM ? (nM - fm) : WGM;
        u.pm = fm + ((wgid % nig) % gsz); u.pn = (wgid % nig) / gsz; return true;
    }
};

template <class Epi, bool ALIGN_EPI>
__device__ __forceinline__ void gemm_phase(LAS unsigned char* lds, const int tid, const Gemm g, const StaticOrder& S, const Epi& E) {
    const int wid = __builtin_amdgcn_readfirstlane(tid >> 6), lane = tid & 63, wr = wid >> 2, wc = wid & 3, fr = lane & 15, fq = lane >> 4;
    const int K = g.K, nt_full = K / BK, nt_split = S.nsplit > 0 ? nt_full / S.nsplit : nt_full;
    const unsigned rsA = g.rowsA > 0 ? 128u : (unsigned)K * 2u, rsB = g.rowsB > 0 ? 128u : (unsigned)K * 2u;
    const size_t kstepA = g.rowsA > 0 ? (size_t)g.rowsA * 128 : (size_t)(BK * 2), kstepB = g.rowsB > 0 ? (size_t)g.rowsB * 128 : (size_t)(BK * 2);
    unsigned voffA[2], voffB[2];
#pragma unroll
    for (int i = 0; i < 2; ++i) { int R, C; stage_rc(tid * 16 + i * 8192, R, C); const int Rb = Epi::PERM ? ((R & ~31) + perm32(R & 31)) : R;
        voffA[i] = (unsigned)R * rsA + (unsigned)C * 2u; voffB[i] = (unsigned)Rb * rsB + (unsigned)C * 2u; }
    const size_t hstepA = (size_t)HALF * rsA, hstepB = (size_t)HALF * rsB;
    const size_t tstepA = 2 * hstepA, tstepB = 2 * hstepB;
    const unsigned ldsw = (unsigned)wid * 1024u;
    const int aoff = lds_byte(wr * 64 + fr, fq * 8), boff = lds_byte(wc * 32 + fr, fq * 8);
#define PG8_SA(b, h) (((b) * 2 + (h)) * HTB)
#define PG8_SB(b, h) ((4 + (b) * 2 + (h)) * HTB)
#define PG8_STAGE(bufoff, gbase, voff) do { _Pragma("unroll") for (int _i = 0; _i < 2; ++_i) \
        __builtin_amdgcn_global_load_lds((const unsigned*)((const char*)(gbase) + (voff)[_i]), (LAS unsigned*)(lds + (bufoff) + ldsw + _i * 8192), 16, 0, 0); } while (0)
#define PG8_LDA(dst, b, h) do { _Pragma("unroll") for (int m = 0; m < 4; ++m) _Pragma("unroll") for (int k = 0; k < 2; ++k) dst[m][k] = *(const LAS bf16x8*)(lds + PG8_SA(b, h) + aoff + m * 2048 + k * 1024); } while (0)
#define PG8_LDB(dst, b, h) do { _Pragma("unroll") for (int n = 0; n < 2; ++n) _Pragma("unroll") for (int k = 0; k < 2; ++k) dst[n][k] = *(const LAS bf16x8*)(lds + PG8_SB(b, h) + boff + n * 2048 + k * 1024); } while (0)
#define PG8_MMA(ai, bj, At, Bt) do { __builtin_amdgcn_s_setprio(1); _Pragma("unroll") for (int m = 0; m < 4; ++m) _Pragma("unroll") for (int n = 0; n < 2; ++n) _Pragma("unroll") for (int k = 0; k < 2; ++k) \
        acc[ai][bj][m][n] = __builtin_amdgcn_mfma_f32_16x16x32_bf16(Bt[n][k], At[m][k], acc[ai][bj][m][n], 0, 0, 0); __builtin_amdgcn_s_setprio(0); } while (0)
#define PG8_WAIT_V(n) asm volatile("s_waitcnt vmcnt(" #n ")" ::: "memory")
#define PG8_WAIT_L(n) asm volatile("s_waitcnt lgkmcnt(" #n ")" ::: "memory")
#define PG8_BAR __builtin_amdgcn_s_barrier()
#define PG8_SCHED __builtin_amdgcn_sched_barrier(0)
    Unit cur, nxt; int ui = 0;
    if (!S.next(0, cur)) return;
    f32x4 acc[2][2][4][2];
#pragma unroll
    for (int a = 0; a < 2; ++a)
#pragma unroll
        for (int b = 0; b < 2; ++b)
#pragma unroll
            for (int m = 0; m < 4; ++m)
#pragma unroll
                for (int n = 0; n < 2; ++n) acc[a][b][m][n] = (f32x4){0.f, 0.f, 0.f, 0.f};
    bf16x8 At[4][2], B0[2][2], B1[2][2];
#define PG8_KOFFA(u) ((u).ks >= 0 ? (size_t)(u).ks * nt_split * kstepA : (size_t)0)
#define PG8_KOFFB(u) ((u).ks >= 0 ? (size_t)(u).ks * nt_split * kstepB : (size_t)0)
    const char* cA = (const char*)g.A + (size_t)cur.pm * tstepA + PG8_KOFFA(cur); const char* cB = (const char*)g.Bt + (size_t)cur.pn * tstepB + PG8_KOFFB(cur);
    PG8_STAGE(PG8_SB(0, 0), cB, voffB); PG8_STAGE(PG8_SB(0, 1), cB + hstepB, voffB); PG8_STAGE(PG8_SA(0, 0), cA, voffA); PG8_STAGE(PG8_SA(0, 1), cA + hstepA, voffA);
    if (wr == 1) PG8_BAR;
    PG8_WAIT_V(2); PG8_BAR;
    PG8_STAGE(PG8_SB(1, 0), cB + kstepB, voffB); PG8_STAGE(PG8_SA(1, 0), cA + kstepA, voffA); PG8_STAGE(PG8_SB(1, 1), cB + hstepB + kstepB, voffB);
    PG8_WAIT_V(6); PG8_BAR;
    for (;;) {
        const bool has_next = S.next(ui + 1, nxt);
        const char* nA = has_next ? (const char*)g.A + (size_t)nxt.pm * tstepA + PG8_KOFFA(nxt) : cA; const char* nB = has_next ? (const char*)g.Bt + (size_t)nxt.pn * tstepB + PG8_KOFFB(nxt) : cB;
        const int nt = cur.ks >= 0 ? nt_split : nt_full;
        for (int t = 0; t < nt; t += 2) {
            if constexpr (Epi::HOOK) { if (t != 0 && (t & 7) == 0) E.hook(acc, cur, (t >> 3) - 1, wr, wc, fr, fq); }
            const bool last = (t == nt - 2);
            const char* a1 = cA + (size_t)(t + 1) * kstepA;
            const char* a2 = last ? nA : cA + (size_t)(t + 2) * kstepA; const char* b2 = last ? nB : cB + (size_t)(t + 2) * kstepB;
            const char* a3 = a2 + kstepA; const char* b3 = b2 + kstepB;
            PG8_LDB(B0, 0, 0); PG8_LDB(B1, 0, 1); PG8_SCHED; PG8_LDA(At, 0, 0); PG8_STAGE(PG8_SA(1, 1), a1 + hstepA, voffA);
            PG8_WAIT_V(8); PG8_WAIT_L(0); PG8_BAR; PG8_MMA(0, 0, At, B0); PG8_MMA(0, 1, At, B1); PG8_BAR; PG8_SCHED;
            PG8_LDA(At, 0, 1); PG8_STAGE(PG8_SB(0, 0), b2, voffB); PG8_STAGE(PG8_SB(0, 1), b2 + hstepB, voffB); PG8_STAGE(PG8_SA(0, 0), a2, voffA);
            PG8_WAIT_V(8); PG8_WAIT_L(0); PG8_BAR; PG8_MMA(1, 0, At, B0); PG8_MMA(1, 1, At, B1); PG8_BAR; PG8_SCHED;
            PG8_LDB(B0, 1, 0); PG8_LDB(B1, 1, 1); PG8_SCHED; PG8_LDA(At, 1, 0); PG8_STAGE(PG8_SA(0, 1), a2 + hstepA, voffA);
            PG8_WAIT_V(8); PG8_WAIT_L(0); PG8_BAR; PG8_MMA(0, 0, At, B0); PG8_MMA(0, 1, At, B1); PG8_BAR; PG8_SCHED;
            PG8_LDA(At, 1, 1); PG8_STAGE(PG8_SB(1, 0), b3, voffB); PG8_STAGE(PG8_SB(1, 1), b3 + hstepB, voffB); PG8_STAGE(PG8_SA(1, 0), a3, voffA);
            PG8_WAIT_V(8); PG8_WAIT_L(0); PG8_BAR; PG8_MMA(1, 0, At, B0); PG8_MMA(1, 1, At, B1); PG8_BAR; PG8_SCHED;
        }
        if constexpr (ALIGN_EPI) { if (wr == 0) PG8_BAR; }
        E(acc, cur, wr, wc, fr, fq);
        if (!has_next) break;
#pragma unroll
        for (int a = 0; a < 2; ++a)
#pragma unroll
            for (int b = 0; b < 2; ++b)
#pragma unroll
                for (int m = 0; m < 4; ++m)
#pragma unroll
                    for (int n = 0; n < 2; ++n) acc[a][b][m][n] = (f32x4){0.f, 0.f, 0.f, 0.f};
        cur = nxt; cA = nA; cB = nB; ++ui;
        if constexpr (ALIGN_EPI) { if (wr == 1) PG8_BAR; }
    }
    PG8_WAIT_V(0);
    if constexpr (!ALIGN_EPI) { if (wr == 0) PG8_BAR; }
    PG8_BAR;
#undef PG8_KOFFA
#undef PG8_KOFFB
#undef PG8_SA
#undef PG8_SB
#undef PG8_STAGE
#undef PG8_LDA
#undef PG8_LDB
#undef PG8_MMA
#undef PG8_WAIT_V
#undef PG8_WAIT_L
#undef PG8_BAR
#undef PG8_SCHED
}

struct EpiIn {
    static constexpr bool PERM = true, HOOK = false;
    bf16_t* Zp; bf16_t* Gp; const float* bgate;
    __device__ __forceinline__ void hook(f32x4 (&)[2][2][4][2], const Unit&, int, int, int, int, int) const {}
    __device__ __forceinline__ void operator()(const f32x4 (&acc)[2][2][4][2], const Unit& u, int wr, int wc, int fr, int fq) const {
        const int row0 = u.pm * BM + wr * 64 + fr; const int colt = u.pn * BM;
        if (colt < ZW) {
            const int col0 = colt + wc * 32 + 8 * fq;
#pragma unroll
            for (int ai = 0; ai < 2; ++ai)
#pragma unroll
                for (int m = 0; m < 4; ++m) { bf16_t* rowp = Zp + (size_t)(row0 + ai * HALF + m * 16) * ZW + col0;
#pragma unroll
                    for (int bj = 0; bj < 2; ++bj) { const f32x4 v0 = acc[ai][bj][m][0], v1 = acc[ai][bj][m][1];
                        u32x4 w; w.x = pk2(v0[0], v0[1]); w.y = pk2(v0[2], v0[3]); w.z = pk2(v1[0], v1[1]); w.w = pk2(v1[2], v1[3]);
                        *(GAS u32x4*)(rowp + bj * HALF) = w; } }
        } else {
            const int col0 = colt - ZW + wc * 32 + 8 * fq;
            f32x4 bv[2][2];
#pragma unroll
            for (int bj = 0; bj < 2; ++bj)
#pragma unroll
                for (int n = 0; n < 2; ++n) bv[bj][n] = *(const GAS f32x4*)(bgate + col0 + bj * HALF + 4 * n);
#pragma unroll
            for (int ai = 0; ai < 2; ++ai)
#pragma unroll
                for (int m = 0; m < 4; ++m) { bf16_t* rowp = Gp + (size_t)(row0 + ai * HALF + m * 16) * GW + col0;
#pragma unroll
                    for (int bj = 0; bj < 2; ++bj) { f32x4 v0 = acc[ai][bj][m][0] + bv[bj][0], v1 = acc[ai][bj][m][1] + bv[bj][1];
#pragma unroll
                        for (int e = 0; e < 4; ++e) { float a = fminf(fmaxf(v0[e], -30.f), 30.f), b = fminf(fmaxf(v1[e], -30.f), 30.f);
                            v0[e] = fast_rcp(1.f + fast_exp2(-a * LOG2E)); v1[e] = fast_rcp(1.f + fast_exp2(-b * LOG2E)); }
                        u32x4 w; w.x = pk2(v0[0], v0[1]); w.y = pk2(v0[2], v0[3]); w.z = pk2(v1[0], v1[1]); w.w = pk2(v1[2], v1[3]);
                        *(GAS u32x4*)(rowp + bj * HALF) = w; } }
        }
    }
};
struct EpiSq {
    static constexpr bool PERM = true, HOOK = false;
    bf16_t* O; int ldc;
    __device__ __forceinline__ void hook(f32x4 (&)[2][2][4][2], const Unit&, int, int, int, int, int) const {}
    __device__ __forceinline__ void operator()(const f32x4 (&acc)[2][2][4][2], const Unit& u, int wr, int wc, int fr, int fq) const {
        const int row0 = u.pm * BM + wr * 64 + fr;
#pragma unroll
        for (int ai = 0; ai < 2; ++ai)
#pragma unroll
            for (int m = 0; m < 4; ++m) { const int row = row0 + ai * HALF + m * 16;
#pragma unroll
                for (int bj = 0; bj < 2; ++bj) { f32x4 v0 = acc[ai][bj][m][0], v1 = acc[ai][bj][m][1];
#pragma unroll
                    for (int e = 0; e < 4; ++e) { const float a = fmaxf(v0[e], 0.f), b = fmaxf(v1[e], 0.f); v0[e] = a * a; v1[e] = b * b; }
                    u32x4 w; w.x = pk2(v0[0], v0[1]); w.y = pk2(v0[2], v0[3]); w.z = pk2(v1[0], v1[1]); w.w = pk2(v1[2], v1[3]);
                    const int kblk = u.pn * 4 + bj * 2 + (wc >> 1);
                    *(GAS u32x4*)(O + ((size_t)kblk * MROWS + row) * 64 + 32 * (wc & 1) + 8 * fq) = w; } }
    }
};
struct EpiMerge {
    static constexpr bool PERM = true, HOOK = true;
    const bf16_t* Gp; bf16_t* O; float* part;
    __device__ __forceinline__ void hook(f32x4 (&acc)[2][2][4][2], const Unit& u, int k, int wr, int wc, int fr, int fq) const {
        int row0 = u.pm * BM + wr * 64 + fr; int col0 = u.pn * BM + wc * 32 + 8 * fq;
        asm volatile("" : "+v"(row0), "+v"(col0));
#pragma unroll
        for (int ai = 0; ai < 2; ++ai) {
            u32x4 ga[4][2], gb[4][2];
#pragma unroll
            for (int m = 0; m < 4; ++m) { const bf16_t* gp = Gp + (size_t)(row0 + ai * HALF + m * 16) * GW + k * DM + col0;
#pragma unroll
                for (int bj = 0; bj < 2; ++bj) { ga[m][bj] = *(const GAS u32x4*)(gp + bj * HALF); gb[m][bj] = *(const GAS u32x4*)(gp + DM + bj * HALF); } }
#pragma unroll
            for (int m = 0; m < 4; ++m)
#pragma unroll
                for (int bj = 0; bj < 2; ++bj) { const u32x4 a = ga[m][bj], b = gb[m][bj];
                    f32x4 r0, r1;
                    r0[0] = bflo(a.x) * fast_rcp(bflo(b.x)); r0[1] = bfhi(a.x) * fast_rcp(bfhi(b.x)); r0[2] = bflo(a.y) * fast_rcp(bflo(b.y)); r0[3] = bfhi(a.y) * fast_rcp(bfhi(b.y));
                    r1[0] = bflo(a.z) * fast_rcp(bflo(b.z)); r1[1] = bfhi(a.z) * fast_rcp(bfhi(b.z)); r1[2] = bflo(a.w) * fast_rcp(bflo(b.w)); r1[3] = bfhi(a.w) * fast_rcp(bfhi(b.w));
                    acc[ai][bj][m][0] *= r0; acc[ai][bj][m][1] *= r1; }
            asm volatile("" ::: "memory");
        }
    }
    __device__ __forceinline__ void operator()(const f32x4 (&acc)[2][2][4][2], const Unit& u, int wr, int wc, int fr, int fq) const {
        const int row0 = u.pm * BM + wr * 64 + fr; const int col0 = u.pn * BM + wc * 32 + 8 * fq;
        const int kg = u.ks >= 0 ? u.ks : 3;
#pragma unroll
        for (int ai = 0; ai < 2; ++ai) {
            u32x4 ga[4][2];
#pragma unroll
            for (int m = 0; m < 4; ++m) { const bf16_t* gp = Gp + (size_t)(row0 + ai * HALF + m * 16) * GW + kg * DM + col0;
#pragma unroll
                for (int bj = 0; bj < 2; ++bj) ga[m][bj] = *(const GAS u32x4*)(gp + bj * HALF); }
#pragma unroll
            for (int m = 0; m < 4; ++m) { bf16_t* rowp = O + (size_t)(row0 + ai * HALF + m * 16) * DM + col0;
                float* prow = part + ((size_t)(u.ks >= 0 ? u.ks : 0) * NCTX + (size_t)(row0 + ai * HALF + m * 16 - NLAT)) * DM + col0;
#pragma unroll
                for (int bj = 0; bj < 2; ++bj) { const u32x4 a = ga[m][bj]; const f32x4 v0 = acc[ai][bj][m][0], v1 = acc[ai][bj][m][1];
                    const f32x4 s0 = {v0[0] * bflo(a.x), v0[1] * bfhi(a.x), v0[2] * bflo(a.y), v0[3] * bfhi(a.y)}, s1 = {v1[0] * bflo(a.z), v1[1] * bfhi(a.z), v1[2] * bflo(a.w), v1[3] * bfhi(a.w)};
                    if (u.ks >= 0) { *(GAS f32x4*)(prow + bj * HALF) = s0; *(GAS f32x4*)(prow + bj * HALF + 4) = s1; }
                    else { u32x4 w; w.x = pk2(s0[0], s0[1]); w.y = pk2(s0[2], s0[3]); w.z = pk2(s1[0], s1[1]); w.w = pk2(s1[2], s1[3]);
                        *(GAS u32x4*)(rowp + bj * HALF) = w; } } }
            asm volatile("" ::: "memory");
        }
    }
};
struct EpiRes {
    static constexpr bool PERM = false, HOOK = false;
    const float* base_lat; const float* base_ctx; float* out; const float* gate; float* part;
    __device__ __forceinline__ void hook(f32x4 (&)[2][2][4][2], const Unit&, int, int, int, int, int) const {}
    __device__ __forceinline__ void operator()(const f32x4 (&acc)[2][2][4][2], const Unit& u, int wr, int wc, int fr, int fq) const {
        const int row0 = u.pm * BM + wr * 64 + fr; const int col0 = u.pn * BM + wc * 32 + 4 * fq;
        const int bslot = u.pm < 32 ? (u.pm >> 3) : 4;
        const float* gp = gate + (size_t)bslot * MODW + col0;
        if (u.ks >= 0) {
            float* pp = part + ((size_t)u.ks * NCTX + (row0 - NLAT)) * DM + col0;
#pragma unroll
            for (int bj = 0; bj < 2; ++bj)
#pragma unroll
                for (int n = 0; n < 2; ++n) { const f32x4 gv = *(const GAS f32x4*)(gp + bj * HALF + n * 16);
#pragma unroll
                    for (int ai = 0; ai < 2; ++ai)
#pragma unroll
                        for (int m = 0; m < 4; ++m) *(GAS f32x4*)(pp + (size_t)(ai * HALF + m * 16) * DM + bj * HALF + n * 16) = gv * acc[ai][bj][m][n]; }
            return;
        }
        const float* bp = (u.pm < 32 ? base_lat + (size_t)row0 * DM : base_ctx + (size_t)(row0 - NLAT) * DM) + col0;
        float* op = out + (size_t)row0 * DM + col0;
        f32x4 tb[1][8];
#define ERES_LOAD(q, bj, n) do { _Pragma("unroll") for (int ai = 0; ai < 2; ++ai) _Pragma("unroll") for (int m = 0; m < 4; ++m) \
            tb[q][ai * 4 + m] = *(const GAS f32x4*)(bp + (size_t)(ai * HALF + m * 16) * DM + (bj) * HALF + (n) * 16); } while (0)
#define ERES_STORE(q, bj, n) do { const f32x4 gv = *(const GAS f32x4*)(gp + (bj) * HALF + (n) * 16); \
            _Pragma("unroll") for (int ai = 0; ai < 2; ++ai) _Pragma("unroll") for (int m = 0; m < 4; ++m) \
                *(GAS f32x4*)(op + (size_t)(ai * HALF + m * 16) * DM + (bj) * HALF + (n) * 16) = tb[q][ai * 4 + m] + gv * acc[ai][bj][m][n]; } while (0)
#pragma unroll
        for (int bj = 0; bj < 2; ++bj)
#pragma unroll
            for (int n = 0; n < 2; ++n) { ERES_LOAD(0, bj, n); asm volatile("" ::: "memory"); ERES_STORE(0, bj, n); asm volatile("" ::: "memory"); }
#undef ERES_LOAD
#undef ERES_STORE
    }
};
}

struct Args { const float* in[21]; float* out; unsigned char* ws; int ph_lo, ph_hi; };

struct Ctx {
    LAS unsigned char* lds; int tid, lane, wave, G, bid;
};
constexpr int ARG_OFF = 131072;
DI const float* ARGP(const Ctx& C, int i) {
    volatile LAS unsigned* p = (volatile LAS unsigned*)(C.lds + ARG_OFF) + 2 * i;
    const unsigned lo = __builtin_amdgcn_readfirstlane(p[0]), hi = __builtin_amdgcn_readfirstlane(p[1]);
    return (const float*)(((unsigned long long)hi << 32) | (unsigned long long)lo);
}
DI unsigned char* ARGWS(const Ctx& C) { return (unsigned char*)ARGP(C, 22); }

struct TrItem { const float* W; bf16_t* WT; int K, N, item, tiled; };
DI void tr_load(const TrItem& T, int lane, f32x4 (&va)[8], f32x4 (&vb)[8]) {
    const int nblk = T.N / 64, kb = T.item / nblk, nb = T.item % nblk, k0 = 64 * kb, n0 = 64 * nb;
    const int nc = lane & 15, q = lane >> 4;
    const float* src = T.W + (size_t)(k0 + 2 * q) * T.N + n0 + 4 * nc;
#pragma unroll
    for (int i = 0; i < 8; ++i) { va[i] = __builtin_nontemporal_load((const GAS f32x4*)(src + (size_t)(8 * i) * T.N)); vb[i] = __builtin_nontemporal_load((const GAS f32x4*)(src + (size_t)(8 * i + 1) * T.N)); }
}
DI void tr_finish(const TrItem& T, int lane, const f32x4 (&va)[8], const f32x4 (&vb)[8], LAS unsigned char* scr) {
    const int nblk = T.N / 64, kb = T.item / nblk, nb = T.item % nblk, k0 = 64 * kb, n0 = 64 * nb;
    const int nc = lane & 15, q = lane >> 4;
#pragma unroll
    for (int i = 0; i < 8; ++i)
#pragma unroll
        for (int e = 0; e < 4; ++e) *(LAS unsigned*)(scr + (4 * nc + e) * 128 + ((i ^ (nc & 7)) * 16) + q * 4) = pk2(va[i][e], vb[i][e]);
    asm volatile("s_waitcnt lgkmcnt(0)" ::: "memory");
    const int c = lane & 7;
#pragma unroll
    for (int j = 0; j < 8; ++j) { const int n = (lane >> 3) + 8 * j; const u32x4 o = *(const LAS u32x4*)(scr + n * 128 + ((c ^ ((n >> 2) & 7)) * 16));
        bf16_t* dst = T.tiled ? T.WT + ((size_t)kb * T.N + n0 + n) * 64 + 8 * c : T.WT + (size_t)(n0 + n) * T.K + k0 + 8 * c;
        *(GAS u32x4*)dst = o; }
    asm volatile("s_waitcnt lgkmcnt(0)" ::: "memory");
}

DI void phase_prep(const Ctx& C) {
    unsigned char* ws = ARGWS(C);
    const int tid = C.tid, lane = C.lane, wave = C.wave;
    {
        LAS float* sl = (LAS float*)(C.lds + 73728);
        LAS float* red = (LAS float*)(C.lds + 73728 + 40960);
        const float* cin = ARGP(C, 1); const float* cctx = ARGP(C, 3);
        { float cvv[5 * DM / NTHREADS];
#pragma unroll
          for (int k = 0; k < 5 * DM / NTHREADS; ++k) { const int i = tid + k * NTHREADS, b = i >> 11, kk = i & 2047; cvv[k] = b < 4 ? cin[b * DM + kk] : cctx[kk]; }
#pragma unroll
          for (int k = 0; k < 5 * DM / NTHREADS; ++k) { const float cv = cvv[k]; sl[tid + k * NTHREADS] = cv / (1.f + __expf(-cv)); } }
        __syncthreads();
        float* mod = (float*)(ws + WS_MOD); const float* wada = ARGP(C, 4); const float* bada = ARGP(C, 5);
        for (int unit = C.bid; unit < 256; unit += C.G) {
            const int l = unit >> 7, j0 = (unit & 127) * 96, cl = lane & 31, ks = lane >> 5;
            f32x4 a0 = {0.f, 0.f, 0.f, 0.f}, a1 = a0, a2 = a0, a3 = a0, a4 = a0;
            if (cl < 24) {
                const int kb = wave * 256 + ks * 128;
                const float* wp = wada + ((size_t)l * DM + kb) * MODW + j0 + 4 * cl;
#pragma unroll 16
                for (int t = 0; t < 128; ++t) { const f32x4 wv = __builtin_nontemporal_load((const GAS f32x4*)(wp + (size_t)t * MODW));     const int k = kb + t;
                    a0 += sl[k] * wv; a1 += sl[DM + k] * wv; a2 += sl[2 * DM + k] * wv; a3 += sl[3 * DM + k] * wv; a4 += sl[4 * DM + k] * wv; }
            }
#pragma unroll
            for (int e = 0; e < 4; ++e) { a0[e] += shx(a0[e], 32, lane); a1[e] += shx(a1[e], 32, lane); a2[e] += shx(a2[e], 32, lane); a3[e] += shx(a3[e], 32, lane); a4[e] += shx(a4[e], 32, lane); }
            if (lane < 24) { LAS float* rp = red + (wave * 5) * 96 + 4 * lane;
                *(LAS f32x4*)(rp) = a0; *(LAS f32x4*)(rp + 96) = a1; *(LAS f32x4*)(rp + 192) = a2; *(LAS f32x4*)(rp + 288) = a3; *(LAS f32x4*)(rp + 384) = a4; }
            __syncthreads();
            if (tid < 480) { const int b = tid / 96, cc = tid % 96; float sm = 0.f;
#pragma unroll
                for (int w = 0; w < 8; ++w) sm += red[(w * 5 + b) * 96 + cc];
                mod[((size_t)l * 5 + b) * MODW + j0 + cc] = sm + bada[(size_t)l * MODW + j0 + cc]; }
            __syncthreads();
        }
    }
    const int gw = C.bid * NWAVES + wave, NGW = C.G * NWAVES;
    const int gt = C.bid * NTHREADS + tid, NGT = C.G * NTHREADS;
    {
        LAS unsigned char* scr = C.lds + wave * 8192;
        constexpr int I_IN = (DM / 64) * (PROJ / 64), I_SQ = (DM / 64) * (DM / 64), I_F1 = (DM / 64) * (DFF / 64), I_F2 = (DFF / 64) * (DM / 64);
        constexpr int I_LAYER = I_IN + 2 * I_SQ + I_F1 + I_F2;
        bf16_t* wt = (bf16_t*)(ws + WS_WT);
        const float* w_in = ARGP(C, 8); const float* w_br = ARGP(C, 17); const float* w_out = ARGP(C, 18); const float* w_f1 = ARGP(C, 19); const float* w_f2 = ARGP(C, 20);
#define TR_DECODE(it_, T_) do { const int l_ = (it_) / I_LAYER; int r_ = (it_) % I_LAYER; bf16_t* wl_ = wt + (size_t)l_ * WT_LAYER; \
            if (r_ < I_IN) { T_ = TrItem{w_in + (size_t)l_ * DM * PROJ, wl_ + WT_IN, DM, PROJ, r_, 0}; } \
            else if ((r_ -= I_IN) < I_SQ) { T_ = TrItem{w_br + (size_t)l_ * DM * DM, wl_ + WT_BR, DM, DM, r_, 0}; } \
            else if ((r_ -= I_SQ) < I_SQ) { T_ = TrItem{w_out + (size_t)l_ * DM * DM, wl_ + WT_OUT, DM, DM, r_, 0}; } \
            else if ((r_ -= I_SQ) < I_F1) { T_ = TrItem{w_f1 + (size_t)l_ * DM * DFF, wl_ + WT_F1, DM, DFF, r_, 0}; } \
            else { r_ -= I_F1; T_ = TrItem{w_f2 + (size_t)l_ * DFF * DM, wl_ + WT_F2, DFF, DM, r_, 1}; } } while (0)
        constexpr int NIT = 2 * I_LAYER;
        f32x4 a0[8], b0[8], a1[8], b1[8]; TrItem T0, T1;
        int it = gw;
        if (it < NIT) { TR_DECODE(it, T0); tr_load(T0, lane, a0, b0); }
        while (it < NIT) {
            const int it1 = it + NGW;
            if (it1 < NIT) { TR_DECODE(it1, T1); tr_load(T1, lane, a1, b1); }
            tr_finish(T0, lane, a0, b0, scr);
            if (it1 >= NIT) break;
            const int it2 = it1 + NGW;
            if (it2 < NIT) { TR_DECODE(it2, T0); tr_load(T0, lane, a0, b0); }
            tr_finish(T1, lane, a1, b1, scr);
            it = it2;
        }
#undef TR_DECODE
    }
    { bf16_t* cwt = (bf16_t*)(ws + WS_CWT); const float* cw = ARGP(C, 13);
      for (int i = gt; i < 2 * 4 * 128 * 128 / 2; i += NGT) { const int c = (i & 63) * 2, e = (i >> 6) & 127, lg = i >> 13;
          const float v0 = cw[((size_t)lg * 128 + c) * 128 + e], v1 = cw[((size_t)lg * 128 + c + 1) * 128 + e];
          *(GAS unsigned*)(cwt + ((size_t)lg * 128 + e) * 128 + c) = pk2(v0, v1); } }
    { float* rc = (float*)(ws + WS_ROPE); float* rs = rc + SEQ * 32;
      for (int i = gt; i < SEQ * 32; i += NGT) { const int t = i >> 5, j = i & 31; const float pos = (float)(j < 16 ? (t >> 6) : (t & 63)); const int f = j & 15;
          const float inv = exp2f(-(float)f * (13.287712379549449f / 16.f)); const float ang = pos * inv;
          const float n = rintf(ang * 0.15915494309189535f); float r = fmaf(-n, 6.28125f, ang); r = fmaf(-n, 0.0019353071795864769f, r);
          rc[i] = __cosf(r); rs[i] = __sinf(r); } }
    if (C.bid == 0 && wave == 0) {
        float* misc = (float*)(ws + WS_MISC); const float* qkg = ARGP(C, 10); const float* rpbp = ARGP(C, 12); const float* snk = ARGP(C, 11);
        for (int l = 0; l < 2; ++l) {
            float gm[6];
#pragma unroll
            for (int j = 0; j < 6; ++j) { float v = fabsf(qkg[l * 384 + j * 64 + lane]);
#pragma unroll
                for (int o = 1; o < 64; o <<= 1) v = fmaxf(v, shx(v, o, lane));
                gm[j] = v; }
            float rm = 0.f;
            { const GAS f32x4* rp4 = (const GAS f32x4*)(rpbp + l * 8 * 15 * 31);
#pragma unroll 8
              for (int i = lane; i < 930; i += 64) { const f32x4 v = rp4[i]; rm = fmaxf(fmaxf(rm, fmaxf(fabsf(v.x), fabsf(v.y))), fmaxf(fabsf(v.z), fabsf(v.w))); } }
            float sm = lane < 8 ? snk[l * 8 + lane] : -1e30f;
#pragma unroll
            for (int o = 1; o < 64; o <<= 1) { rm = fmaxf(rm, shx(rm, o, lane)); sm = fmaxf(sm, shx(sm, o, lane)); }
            if (lane == 0) { const float k = 64.f * QSCALE * 1.01f;
                misc[8 + 4 * l] = fmaxf(k * gm[0] * gm[1], sm * LOG2E); misc[9 + 4 * l] = k * gm[2] * gm[3] + rm * LOG2E; misc[10 + 4 * l] = k * gm[4] * gm[5]; }
        }
    }
    if (C.bid == 0 && tid < 2) { const int l = tid; const float* dl = ARGP(C, 15) + l * 256; float s1 = 0.f, s2 = 0.f;
        for (int i = 0; i < 64; ++i) { s1 += dl[i] * dl[64 + i]; s2 += dl[128 + i] * dl[192 + i]; }
        const float li = 0.8f - 0.6f * expf(-0.3f * (float)l); float* misc = (float*)(ws + WS_MISC);
        misc[l] = expf(s1) - expf(s2) + li; misc[2 + l] = 1.f - li; }
}

DI void phase_norm(const Ctx& C, const float* xlat, const float* xctx, bf16_t* H, const float* gn, const float* modl, int sh_off, int sc_off, int nrows, const float* part, int nsplit, float* xs_out) {
    const int gw = C.bid * NWAVES + C.wave, NGW = C.G * NWAVES, lane = C.lane;
    for (int row = gw; row < nrows; row += NGW) {
        const int b = row < NLAT ? (row >> 11) : 4;
        const float* mb = modl + (size_t)b * MODW;
        const GAS f32x4* xr = (const GAS f32x4*)(row < NLAT ? xlat + (size_t)row * DM : xctx + (size_t)(row - NLAT) * DM) + lane;
        f32x4 v[8]; float s = 0.f;
#pragma unroll
        for (int j = 0; j < 8; ++j) v[j] = xr[64 * j];
        if (part != nullptr && row >= NLAT) {
            for (int kb = 0; kb < nsplit; kb += 4) {
                f32x4 t[4][8];
#pragma unroll
                for (int q = 0; q < 4; ++q) { const GAS f32x4* pr = (const GAS f32x4*)(part + ((size_t)(kb + q) * NCTX + (row - NLAT)) * DM) + lane;
#pragma unroll
                    for (int j = 0; j < 8; ++j) t[q][j] = pr[64 * j]; }
#pragma unroll
                for (int j = 0; j < 8; ++j) v[j] += (t[0][j] + t[1][j]) + (t[2][j] + t[3][j]); }
            GAS f32x4* xo = (GAS f32x4*)(xs_out + (size_t)row * DM) + lane;
#pragma unroll
            for (int j = 0; j < 8; ++j) xo[64 * j] = v[j];
        }
#pragma unroll
        for (int j = 0; j < 8; ++j) s += (v[j].x * v[j].x + v[j].y * v[j].y) + (v[j].z * v[j].z + v[j].w * v[j].w);
        const float rstd = 1.f / sqrtf(wave_sum(s, lane) * (1.f / DM) + EPS);
        GAS u32x2* o8 = (GAS u32x2*)(H + (size_t)row * DM) + lane;
#pragma unroll
        for (int j = 0; j < 8; ++j) { const int col = 4 * lane + 256 * j;
            const f32x4 g = *(const GAS f32x4*)(gn + col), sc = *(const GAS f32x4*)(mb + sc_off + col), sh = *(const GAS f32x4*)(mb + sh_off + col);
            const f32x4 y = v[j] * rstd * g * (sc + 1.f) + sh;
            u32x2 w; w.x = pk2(y.x, y.y); w.y = pk2(y.z, y.w); o8[64 * j] = w; }
    }
}

DI void phase_qknorm(const Ctx& C, bf16_t* Z, const float* qkg  , const float* ropec, const float* ropes) {
    const int lane = C.lane; const int gidx = (C.bid * NTHREADS + C.tid) >> 3, NG = (C.G * NTHREADS) >> 3, t8 = lane & 7;
    constexpr int NIT = MROWS * 42;
    for (int it0 = gidx; it0 < NIT; it0 += 4 * NG) {
        u32x4 raw[4]; bf16_t* pp[4];
#pragma unroll
        for (int j = 0; j < 4; ++j) { const int it = min(it0 + j * NG, NIT - 1); const int row = it / 42, s = it % 42;
            const int col = s < 8 ? Z_AQ + 64 * s : s < 10 ? Z_AK + 64 * (s - 8) : s < 18 ? Z_BQ + 64 * (s - 10) : s < 26 ? Z_BK + 64 * (s - 18) : s < 34 ? Z_DQ + 64 * (s - 26) : Z_DK + 64 * (s - 34);
            pp[j] = Z + (size_t)row * ZW + col + 8 * t8; raw[j] = *(const GAS u32x4*)pp[j]; }
#pragma unroll
        for (int j = 0; j < 4; ++j) {
            const int it = it0 + j * NG; const int itc = min(it, NIT - 1); const int row = itc / 42, s = itc % 42;
            const int gi = s < 8 ? 0 : s < 10 ? 1 : s < 18 ? 2 : s < 26 ? 3 : s < 34 ? 4 : 5;
            const bool rope = (gi != 2 && gi != 3), isq = !(gi & 1);
            const u32x4 rw = raw[j];
            float x[8] = {bflo(rw.x), bfhi(rw.x), bflo(rw.y), bfhi(rw.y), bflo(rw.z), bfhi(rw.z), bflo(rw.w), bfhi(rw.w)};
            float ss = 0.f;
#pragma unroll
            for (int i = 0; i < 8; ++i) ss += x[i] * x[i];
            ss += shx(ss, 1, lane); ss += shx(ss, 2, lane); ss += shx(ss, 4, lane);
            const float rstd = 1.f / sqrtf(ss * (1.f / 64.f) + EPS);
            const f32x4 g0 = *(const GAS f32x4*)(qkg + gi * 64 + 8 * t8), g1 = *(const GAS f32x4*)(qkg + gi * 64 + 8 * t8 + 4);
            x[0] *= rstd * g0.x; x[1] *= rstd * g0.y; x[2] *= rstd * g0.z; x[3] *= rstd * g0.w; x[4] *= rstd * g1.x; x[5] *= rstd * g1.y; x[6] *= rstd * g1.z; x[7] *= rstd * g1.w;
            float px[8];
#pragma unroll
            for (int i = 0; i < 8; ++i) px[i] = shx(x[i], 2, lane);
            if (rope && row < NLAT) {
                const int tok = row & (SEQ - 1), ab = tok * 32 + (t8 & 1) * 8 + (t8 >> 2) * 16;
                const f32x4 c0 = *(const GAS f32x4*)(ropec + ab), c1 = *(const GAS f32x4*)(ropec + ab + 4), s0 = *(const GAS f32x4*)(ropes + ab), s1 = *(const GAS f32x4*)(ropes + ab + 4);
                const float cc[8] = {c0.x, c0.y, c0.z, c0.w, c1.x, c1.y, c1.z, c1.w}, sn[8] = {s0.x, s0.y, s0.z, s0.w, s1.x, s1.y, s1.z, s1.w};
                const float sg = (t8 & 2) ? 1.f : -1.f;
#pragma unroll
                for (int i = 0; i < 8; ++i) x[i] = x[i] * cc[i] + sg * px[i] * sn[i];
            }
            if (isq) {
#pragma unroll
                for (int i = 0; i < 8; ++i) x[i] *= QSCALE;
            }
            u32x4 w; w.x = pk2(x[0], x[1]); w.y = pk2(x[2], x[3]); w.z = pk2(x[4], x[5]); w.w = pk2(x[6], x[7]);
            if (it < NIT) *(GAS u32x4*)pp[j] = w;
        }
    }
}

template <int MODE> struct AttnCfg {
    static constexpr int NS = MODE == 1 ? 1 : 2, DV = MODE == 2 ? 128 : 64, KW = MODE == 2 ? 128 : 64, KST = KW + 8, NDVB = DV / 16, NVC = DV / 64, NKC = KW / 64;
};
constexpr int AT_BUF = 36864, AT_KS = 0, AT_VT = 17408, AT_BT = 2 * AT_BUF, VST = 72;

template <int MODE, int NKB>
DI void attn_tile(const LAS bf16_t* Ks, const LAS bf16_t* Vt, const bf16x8 (&qf)[AttnCfg<MODE>::NS][2], const float negm, float (&lsum)[AttnCfg<MODE>::NS],
                  f32x4 (&o)[AttnCfg<MODE>::NS][AttnCfg<MODE>::NDVB], int kb0  , int l15, int quad, int lane, bool masked, int mp, const LAS float* brow) {
    using Cf = AttnCfg<MODE>; constexpr int NS = Cf::NS, KST = Cf::KST, NDVB = Cf::NDVB;
    f32x4 st[NS][NKB];
#pragma unroll
    for (int i = 0; i < NKB; ++i) { const LAS bf16_t* kp = Ks + (kb0 + 16 * i + l15) * KST + 8 * quad;
#pragma unroll
        for (int s = 0; s < NS; ++s) st[s][i] = (f32x4){negm, negm, negm, negm};
#pragma unroll
        for (int kc = 0; kc < 2; ++kc) {
            if (MODE == 2) {
#pragma unroll
                for (int s = 0; s < NS; ++s) { const bf16x8 a = *(const LAS bf16x8*)(kp + 64 * s + 32 * kc); st[s][i] = __builtin_amdgcn_mfma_f32_16x16x32_bf16(a, qf[s][kc], st[s][i], 0, 0, 0); }
                if (kc == 1 && (i & 1)) __builtin_amdgcn_sched_barrier(0);
            } else { const bf16x8 a = *(const LAS bf16x8*)(kp + 32 * kc);
#pragma unroll
                for (int s = 0; s < NS; ++s) st[s][i] = __builtin_amdgcn_mfma_f32_16x16x32_bf16(a, qf[s][kc], st[s][i], 0, 0, 0); } } }
    if (MODE == 2) __builtin_amdgcn_sched_barrier(0);
    if (masked) {
        if (MODE == 0) {
#pragma unroll
            for (int i = 0; i < NKB; ++i)
#pragma unroll
                for (int r = 0; r < 4; ++r) { const int d = mp - (kb0 + 16 * i + 4 * quad + r); const bool bad = (d > 128) || (d < -128);
#pragma unroll
                    for (int s = 0; s < NS; ++s) st[s][i][r] = bad ? NEGBIG : st[s][i][r]; }
        }
        if (MODE == 1) {
#pragma unroll
            for (int i = 0; i < NKB; ++i)
#pragma unroll
                for (int r = 0; r < 4; ++r) { const int key = kb0 + 16 * i + 4 * quad + r; const bool valid = (key >= mp) && (key < mp + 16);
                    const float bias = valid ? brow[key] : 0.f; st[0][i][r] = valid ? st[0][i][r] + bias : NEGBIG; }
        }
    }
    bf16x8 pf[NS][NKB / 2];
#pragma unroll
    for (int s = 0; s < NS; ++s) {
        if (MODE == 2) __builtin_amdgcn_sched_barrier(0);
        float ps = 0.f;
#pragma unroll
        for (int i = 0; i < NKB; ++i)
#pragma unroll
            for (int r = 0; r < 4; ++r) { const float p = fast_exp2(st[s][i][r]); st[s][i][r] = p; ps += p; }
        lsum[s] += ps;
#pragma unroll
        for (int c = 0; c < NKB / 2; ++c) { u32x4 pw; pw.x = pk2(st[s][2 * c][0], st[s][2 * c][1]); pw.y = pk2(st[s][2 * c][2], st[s][2 * c][3]); pw.z = pk2(st[s][2 * c + 1][0], st[s][2 * c + 1][1]); pw.w = pk2(st[s][2 * c + 1][2], st[s][2 * c + 1][3]);
            pf[s][c] = __builtin_bit_cast(bf16x8, pw); }
    }
    if (MODE == 2) __builtin_amdgcn_sched_barrier(0);
#pragma unroll
    for (int d = 0; d < NDVB; ++d)
#pragma unroll
        for (int c = 0; c < NKB / 2; ++c) { const LAS bf16_t* vp = Vt + (16 * d + l15) * VST + kb0 + 32 * c + 4 * quad;
            const u32x2 lo = *(const LAS u32x2*)vp, hi = *(const LAS u32x2*)(vp + 16);
            u32x4 av; av.x = lo.x; av.y = lo.y; av.z = hi.x; av.w = hi.y; const bf16x8 avv = __builtin_bit_cast(bf16x8, av);
#pragma unroll
            for (int s = 0; s < NS; ++s) o[s][d] = __builtin_amdgcn_mfma_f32_16x16x32_bf16(avv, pf[s][c], o[s][d], 0, 0, 0);
            if (MODE == 2 && c == NKB / 2 - 1 && (d & 1)) __builtin_amdgcn_sched_barrier(0); }
}

template <int MODE>
DI void attn_unit(const Ctx& C, const bf16_t* __restrict__ Z, bf16_t* __restrict__ Y, int b, int qsel, int hsel, bool ctxq,
                  const float* sinkp, const float* rpb_h, float lam, float post_scale, const float* subln, const float mref) {
    using Cf = AttnCfg<MODE>; constexpr int NS = Cf::NS, KST = Cf::KST, NDVB = Cf::NDVB, NVC = Cf::NVC, NKC = Cf::NKC;
    const int tid = C.tid, lane = C.lane, w = C.wave, l15 = lane & 15, quad = lane >> 4;
    constexpr int QB = MODE == 0 ? 64 : 128;
    const int qi = MODE == 0 ? 16 * (w & 3) + l15 : 16 * w + l15;
    const int qrow = (ctxq ? NLAT + 256 * b : b * SEQ) + QB * qsel + qi;
    int qcol[NS], kcol, vcol, ycol[NS];
    if (MODE == 0) { const int h0 = 4 * hsel + 2 * (w >> 2); qcol[0] = Z_AQ + 64 * h0; qcol[NS - 1] = Z_AQ + 64 * (h0 + 1); kcol = Z_AK + 64 * hsel; vcol = Z_AV + 64 * hsel; ycol[0] = 64 * h0; ycol[NS - 1] = 64 * (h0 + 1); }
    else if (MODE == 1) { qcol[0] = Z_BQ + 64 * hsel; kcol = Z_BK + 64 * hsel; vcol = Z_BV + 64 * hsel; ycol[0] = 512 + 64 * hsel; }
    else { qcol[0] = Z_DQ + 128 * hsel; qcol[NS - 1] = qcol[0] + 64; kcol = Z_DK + 128 * hsel; vcol = Z_DV + 128 * hsel; ycol[0] = 1536 + 128 * hsel; ycol[NS - 1] = ycol[0]; }
    int lt0 = 0, nlat = 0;
    if (!ctxq) {
        if (MODE == 0) { lt0 = max(0, qsel - 2); nlat = min(31, qsel + 2) - lt0 + 1; }
        else if (MODE == 1) { const int rs0 = min(max(2 * qsel - 4, 0), 24), rs1 = min(max(2 * qsel - 3, 0), 24); lt0 = rs0; nlat = rs1 + 8 - rs0; }
        else { lt0 = 0; nlat = 32; }
    }
    const int nt = 4 + nlat;
    LAS bf16_t* lds16 = (LAS bf16_t*)C.lds;
    LAS float* bt = (LAS float*)(C.lds + AT_BT);
    const int qpos = 64 * qsel + qi;
    const int grow_q = 2 * qsel + (w >> 2), qcp = 16 * (w & 3) + l15;
    const int cs_q = min(max(qcp - 8, 0), 48), rs_r = min(max(grow_q - 4, 0), 24);
    const int kb0_lat = min(max(16 * (w & 3) - 8, 0), 32);
    bf16x8 qf[NS][2];
#pragma unroll
    for (int s = 0; s < NS; ++s) { const bf16_t* qp = Z + (size_t)qrow * ZW + qcol[s] + 8 * quad; qf[s][0] = *(const GAS bf16x8*)(qp); qf[s][1] = *(const GAS bf16x8*)(qp + 32); }
    const float negm = -mref;
    float lsum[NS]; f32x4 o[NS][NDVB];
#pragma unroll
    for (int s = 0; s < NS; ++s) { lsum[s] = 0.f;
#pragma unroll
        for (int d = 0; d < NDVB; ++d) o[s][d] = (f32x4){0.f, 0.f, 0.f, 0.f}; }
    if (MODE == 0) {
#pragma unroll
        for (int s = 0; s < NS; ++s) lsum[s] = quad == 0 ? fast_exp2(sinkp[4 * hsel + 2 * (w >> 2) + s] * LOG2E - mref) : 0.f; }
    u32x4 kA[NKC], vA[NVC], kB[NKC], vB[NVC];
    const int krow = tid >> 3, kch = tid & 7;
#define TILE_ROW(t) ((t) < 4 ? (NLAT + 256 * b + 64 * (t)) : (b * SEQ + 64 * (lt0 + (t) - 4)))
    const int vp2 = 2 * (lane & 31), vhs = lane >> 5;
    const unsigned koff = (unsigned)(krow * ZW + kcol + 8 * kch), voff = NVC == 2 ? (unsigned)(vp2 * ZW + vcol + 8 * (2 * w + vhs)) : (unsigned)(lane * ZW + vcol + 8 * w);
#define ISSUE(t, KR, VR) do { const GAS bf16_t* tb_ = (const GAS bf16_t*)Z + (size_t)TILE_ROW(t) * ZW; \
        _Pragma("unroll") for (int j_ = 0; j_ < NKC; ++j_) KR[j_] = *(const GAS u32x4*)(tb_ + koff + 64 * j_); \
        if (NVC == 2) { VR[0] = *(const GAS u32x4*)(tb_ + voff); VR[NVC - 1] = *(const GAS u32x4*)(tb_ + voff + ZW); } \
        else { VR[0] = *(const GAS u32x4*)(tb_ + voff); } } while (0)
#define VPK_LO(a, b) (((a) & 0xffffu) | ((b) << 16))
#define VPK_HI(a, b) (((a) >> 16) | ((b) & 0xffff0000u))
#define WRITE(bi, KR, VR) do { LAS bf16_t* ks_ = lds16 + ((bi) * AT_BUF + AT_KS) / 2; LAS bf16_t* vt_ = lds16 + ((bi) * AT_BUF + AT_VT) / 2; \
        _Pragma("unroll") for (int j_ = 0; j_ < NKC; ++j_) *(LAS u32x4*)(ks_ + krow * KST + 64 * j_ + 8 * kch) = KR[j_]; \
        if (NVC == 2) { LAS unsigned* p_ = (LAS unsigned*)(vt_ + (8 * (2 * w + vhs)) * VST + vp2); const u32x4 a_ = VR[0], b_ = VR[NVC - 1]; \
            p_[0] = VPK_LO(a_.x, b_.x); p_[VST / 2] = VPK_HI(a_.x, b_.x); p_[2 * (VST / 2)] = VPK_LO(a_.y, b_.y); p_[3 * (VST / 2)] = VPK_HI(a_.y, b_.y); \
            p_[4 * (VST / 2)] = VPK_LO(a_.z, b_.z); p_[5 * (VST / 2)] = VPK_HI(a_.z, b_.z); p_[6 * (VST / 2)] = VPK_LO(a_.w, b_.w); p_[7 * (VST / 2)] = VPK_HI(a_.w, b_.w); } \
        else { LAS bf16_t* p_ = vt_ + (8 * w) * VST + lane; const u32x4 r_ = VR[0]; \
            p_[0] = (bf16_t)(r_.x & 0xffffu); p_[VST] = (bf16_t)(r_.x >> 16); p_[2 * VST] = (bf16_t)(r_.y & 0xffffu); p_[3 * VST] = (bf16_t)(r_.y >> 16); \
            p_[4 * VST] = (bf16_t)(r_.z & 0xffffu); p_[5 * VST] = (bf16_t)(r_.z >> 16); p_[6 * VST] = (bf16_t)(r_.w & 0xffffu); p_[7 * VST] = (bf16_t)(r_.w >> 16); } } while (0)
    ISSUE(0, kA, vA); ISSUE(1, kB, vB);
    __syncthreads();
    if (MODE == 1 && !ctxq) { for (int i = tid; i < 15 * 31; i += NTHREADS) bt[i] = rpb_h[i] * LOG2E; }
    WRITE(0, kA, vA); ISSUE(2, kA, vA);
    __syncthreads();
    for (int t = 0; t < nt; ++t) {
        if (t + 1 < nt) {
            if ((t + 1) & 1) { WRITE(1, kB, vB); if (t + 3 < nt) ISSUE(t + 3, kB, vB); }
            else { WRITE(0, kA, vA); if (t + 3 < nt) ISSUE(t + 3, kA, vA); }
        }
        const LAS bf16_t* Ks = lds16 + ((t & 1) * AT_BUF + AT_KS) / 2; const LAS bf16_t* Vt = lds16 + ((t & 1) * AT_BUF + AT_VT) / 2;
        const int ltile = lt0 + t - 4;
        if (MODE == 2) attn_tile<MODE, 4>(Ks, Vt, qf, negm, lsum, o, 0, l15, quad, lane, false, 0, bt);
        else if (MODE == 0) { const int qlo = 64 * qsel + 16 * (w & 3); const bool active = (t < 4) || ((64 * ltile + 63 >= qlo - 128) && (64 * ltile <= qlo + 15 + 128));
            if (active) attn_tile<MODE, 4>(Ks, Vt, qf, negm, lsum, o, 0, l15, quad, lane, t >= 4, qpos - 64 * ltile, bt); }
        else { if (t < 4) attn_tile<MODE, 4>(Ks, Vt, qf, negm, lsum, o, 0, l15, quad, lane, false, 0, bt);
            else { const bool active = (ltile >= rs_r) && (ltile < rs_r + 8);
                if (active) attn_tile<MODE, 2>(Ks, Vt, qf, negm, lsum, o, kb0_lat, l15, quad, lane, true, cs_q, bt + (ltile - grow_q + 7) * 31 + 15 - qcp); } }
        __syncthreads();
    }
#undef ISSUE
#undef WRITE
#undef VPK_LO
#undef VPK_HI
#undef TILE_ROW
    float linv[NS];
#pragma unroll
    for (int s = 0; s < NS; ++s) { float l = lsum[s]; l += shx(l, 16, lane); l += shx(l, 32, lane); linv[s] = 1.f / l; }
    if (MODE != 2) {
#pragma unroll
        for (int s = 0; s < NS; ++s) { bf16_t* yp = Y + (size_t)qrow * DM + ycol[s] + 4 * quad;
#pragma unroll
            for (int d = 0; d < NDVB; ++d) { const f32x4 v = o[s][d] * linv[s]; u32x2 wv; wv.x = pk2(v[0], v[1]); wv.y = pk2(v[2], v[3]); *(GAS u32x2*)(yp + 16 * d) = wv; } }
    } else {
        bf16_t* yp = Y + (size_t)qrow * DM + ycol[0] + 4 * quad;
        f32x4 r[NDVB]; float ss = 0.f; const float l2 = lam * linv[NS - 1];
#pragma unroll
        for (int d = 0; d < NDVB; ++d) { r[d] = o[0][d] * linv[0] - o[NS - 1][d] * l2; ss += (r[d][0] * r[d][0] + r[d][1] * r[d][1]) + (r[d][2] * r[d][2] + r[d][3] * r[d][3]); }
        ss += shx(ss, 16, lane); ss += shx(ss, 32, lane);
        const float rs = post_scale / sqrtf(ss * (1.f / 128.f) + EPS);
#pragma unroll
        for (int d = 0; d < NDVB; ++d) { const f32x4 g = *(const GAS f32x4*)(subln + 16 * d + 4 * quad); const f32x4 v = r[d] * rs * g;
            u32x2 wv; wv.x = pk2(v[0], v[1]); wv.y = pk2(v[2], v[3]); *(GAS u32x2*)(yp + 16 * d) = wv; }
    }
}

typedef float f32x16 __attribute__((ext_vector_type(16)));
DI void attn_unit_d32(const Ctx& C, const bf16_t* __restrict__ Z, bf16_t* __restrict__ Y, int b, int qsel, int hsel, bool ctxq, float lam, float post_scale, const float* subln, const float mref) {
    constexpr int KST = 136, VST = 72, AT_VT = 64 * 136 * 2;
    const int tid = C.tid, lane = C.lane, w = C.wave, l31 = lane & 31, hh = lane >> 5, sm = w >> 2, qg = w & 3;
    const int qrow = (ctxq ? NLAT + 256 * b : b * SEQ) + 128 * qsel + 32 * qg + l31;
    const int qcol = Z_DQ + 128 * hsel + 64 * sm, kcol = Z_DK + 128 * hsel, vcol = Z_DV + 128 * hsel, ycol = 1536 + 128 * hsel;
    const int nt = ctxq ? 4 : 36;
    LAS bf16_t* lds16 = (LAS bf16_t*)C.lds;
    bf16x8 qf[4];
#pragma unroll
    for (int ks = 0; ks < 4; ++ks) qf[ks] = *(const GAS bf16x8*)(Z + (size_t)qrow * ZW + qcol + 16 * ks + 8 * hh);
    const float negm = -mref;
    f32x16 o[4]; float lsum = 0.f;
#pragma unroll
    for (int d = 0; d < 4; ++d)
#pragma unroll
        for (int r = 0; r < 16; ++r) o[d][r] = 0.f;
    u32x4 kA[2], vA[2], kB[2], vB[2];
    const int krow = tid >> 3, kch = tid & 7, vp2 = 2 * (lane & 31), vhs = lane >> 5;
#define TILE_ROW(t) ((t) < 4 ? (NLAT + 256 * b + 64 * (t)) : (b * SEQ + 64 * ((t) - 4)))
    const unsigned koff = (unsigned)(krow * ZW + kcol + 8 * kch), voff = (unsigned)(vp2 * ZW + vcol + 8 * (2 * w + vhs));
#define ISSUE(t, KR, VR) do { const GAS bf16_t* tb_ = (const GAS bf16_t*)Z + (size_t)TILE_ROW(t) * ZW; \
        KR[0] = *(const GAS u32x4*)(tb_ + koff); KR[1] = *(const GAS u32x4*)(tb_ + koff + 64); \
        VR[0] = *(const GAS u32x4*)(tb_ + voff); VR[1] = *(const GAS u32x4*)(tb_ + voff + ZW); } while (0)
#define VPK_LO(a, b) (((a) & 0xffffu) | ((b) << 16))
#define VPK_HI(a, b) (((a) >> 16) | ((b) & 0xffff0000u))
#define WRITE(bi, KR, VR) do { LAS bf16_t* ks_ = lds16 + ((bi) * AT_BUF) / 2; LAS bf16_t* vt_ = lds16 + ((bi) * AT_BUF + AT_VT) / 2; \
        *(LAS u32x4*)(ks_ + krow * KST + 8 * kch) = KR[0]; *(LAS u32x4*)(ks_ + krow * KST + 64 + 8 * kch) = KR[1]; \
        LAS unsigned* p_ = (LAS unsigned*)(vt_ + (8 * (2 * w + vhs)) * VST + vp2); const u32x4 a_ = VR[0], b_ = VR[1]; \
        p_[0] = VPK_LO(a_.x, b_.x); p_[VST / 2] = VPK_HI(a_.x, b_.x); p_[2 * (VST / 2)] = VPK_LO(a_.y, b_.y); p_[3 * (VST / 2)] = VPK_HI(a_.y, b_.y); \
        p_[4 * (VST / 2)] = VPK_LO(a_.z, b_.z); p_[5 * (VST / 2)] = VPK_HI(a_.z, b_.z); p_[6 * (VST / 2)] = VPK_LO(a_.w, b_.w); p_[7 * (VST / 2)] = VPK_HI(a_.w, b_.w); } while (0)
    ISSUE(0, kA, vA); ISSUE(1, kB, vB);
    __syncthreads();
    WRITE(0, kA, vA); ISSUE(2, kA, vA);
    __syncthreads();
    for (int t = 0; t < nt; ++t) {
        if (t + 1 < nt) {
            if ((t + 1) & 1) { WRITE(1, kB, vB); if (t + 3 < nt) ISSUE(t + 3, kB, vB); }
            else { WRITE(0, kA, vA); if (t + 3 < nt) ISSUE(t + 3, kA, vA); }
        }
        const LAS bf16_t* Ks = lds16 + ((t & 1) * AT_BUF) / 2 + 64 * sm; const LAS bf16_t* Vt = lds16 + ((t & 1) * AT_BUF + AT_VT) / 2;
        f32x16 st[2];
#pragma unroll
        for (int kb = 0; kb < 2; ++kb) {
#pragma unroll
            for (int r = 0; r < 16; ++r) st[kb][r] = negm;
#pragma unroll
            for (int ks = 0; ks < 4; ++ks) { const bf16x8 a = *(const LAS bf16x8*)(Ks + (32 * kb + l31) * KST + 16 * ks + 8 * hh);
                st[kb] = __builtin_amdgcn_mfma_f32_32x32x16_bf16(a, qf[ks], st[kb], 0, 0, 0); } }
        bf16x8 pf[2][2]; float ps = 0.f;
#pragma unroll
        for (int kb = 0; kb < 2; ++kb) {
#pragma unroll
            for (int r = 0; r < 16; ++r) { const float p = fast_exp2(st[kb][r]); st[kb][r] = p; ps += p; }
#pragma unroll
            for (int s = 0; s < 2; ++s) { u32x4 pw; pw.x = pk2(st[kb][8 * s], st[kb][8 * s + 1]); pw.y = pk2(st[kb][8 * s + 2], st[kb][8 * s + 3]); pw.z = pk2(st[kb][8 * s + 4], st[kb][8 * s + 5]); pw.w = pk2(st[kb][8 * s + 6], st[kb][8 * s + 7]);
                pf[kb][s] = __builtin_bit_cast(bf16x8, pw); } }
        lsum += ps;
#pragma unroll
        for (int d = 0; d < 4; ++d)
#pragma unroll
            for (int kb = 0; kb < 2; ++kb)
#pragma unroll
                for (int s = 0; s < 2; ++s) { const LAS bf16_t* vp = Vt + (32 * d + l31) * VST + 32 * kb + 16 * s + 4 * hh;
                    const u32x2 lo = *(const LAS u32x2*)vp, hi = *(const LAS u32x2*)(vp + 8);
                    u32x4 av; av.x = lo.x; av.y = lo.y; av.z = hi.x; av.w = hi.y;
                    o[d] = __builtin_amdgcn_mfma_f32_32x32x16_bf16(__builtin_bit_cast(bf16x8, av), pf[kb][s], o[d], 0, 0, 0); }
        __syncthreads();
    }
#undef ISSUE
#undef WRITE
#undef VPK_LO
#undef VPK_HI
#undef TILE_ROW
    float l = lsum; l += shx(l, 32, lane); const float linv = 1.f / l;
    LAS float* X = (LAS float*)C.lds + (32 * qg + l31) * 132;
    if (sm == 1) {
#pragma unroll
        for (int d = 0; d < 4; ++d)
#pragma unroll
            for (int g = 0; g < 4; ++g) { const f32x4 v = {o[d][4 * g] * linv, o[d][4 * g + 1] * linv, o[d][4 * g + 2] * linv, o[d][4 * g + 3] * linv};
                *(LAS f32x4*)(X + 32 * d + 8 * g + 4 * hh) = v; }
    }
    __syncthreads();
    if (sm == 0) {
        f32x4 r[4][4]; float ss = 0.f;
#pragma unroll
        for (int d = 0; d < 4; ++d)
#pragma unroll
            for (int g = 0; g < 4; ++g) { const f32x4 x2 = *(const LAS f32x4*)(X + 32 * d + 8 * g + 4 * hh);
                const f32x4 x1 = {o[d][4 * g] * linv, o[d][4 * g + 1] * linv, o[d][4 * g + 2] * linv, o[d][4 * g + 3] * linv};
                r[d][g] = x1 - x2 * lam; ss += (r[d][g][0] * r[d][g][0] + r[d][g][1] * r[d][g][1]) + (r[d][g][2] * r[d][g][2] + r[d][g][3] * r[d][g][3]); }
        ss += shx(ss, 32, lane);
        const float rs = post_scale / sqrtf(ss * (1.f / 128.f) + EPS);
        bf16_t* yp = Y + (size_t)qrow * DM + ycol;
#pragma unroll
        for (int d = 0; d < 4; ++d)
#pragma unroll
            for (int g = 0; g < 4; ++g) { const int dv = 32 * d + 8 * g + 4 * hh; const f32x4 gn = *(const GAS f32x4*)(subln + dv); const f32x4 v = r[d][g] * rs * gn;
                u32x2 wv; wv.x = pk2(v[0], v[1]); wv.y = pk2(v[2], v[3]); *(GAS u32x2*)(yp + dv) = wv; }
    }
    __syncthreads();
}

DI void pool_unit(const Ctx& C, const bf16_t* __restrict__ Z, bf16_t* __restrict__ Y, const bf16_t* cwT  , const float* cscale, int tile, int g) {
    const int tid = C.tid, lane = C.lane, w = C.wave, l15 = lane & 15, quad = lane >> 4;
    const int R0 = tile * 64;
    int S0, S1; if (R0 < NLAT) { S0 = R0 & ~(SEQ - 1); S1 = S0 + SEQ; } else { S0 = NLAT + ((R0 - NLAT) & ~(CTXL - 1)); S1 = S0 + CTXL; }
    LAS float* U = (LAS float*)C.lds;
    LAS bf16_t* P = (LAS bf16_t*)(C.lds + 80 * 132 * 4);
    __syncthreads();
    { u32x4 vv[3];
#pragma unroll
      for (int k = 0; k < 3; ++k) { const int i = tid + k * NTHREADS, rr = i >> 4, ch = i & 15, grow = R0 - 8 + rr;
          vv[k] = (u32x4){0u, 0u, 0u, 0u};
          if (i < 80 * 16 && grow >= S0 && grow < S1) vv[k] = *(const GAS u32x4*)(Z + (size_t)grow * ZW + Z_CU + 128 * g + 8 * ch); }
#pragma unroll
      for (int k = 0; k < 3; ++k) { const int i = tid + k * NTHREADS, rr = i >> 4, ch = i & 15; const u32x4 v = vv[k];
          if (i < 80 * 16) { LAS float* up = U + rr * 132 + 8 * ch;
              up[0] = bflo(v.x); up[1] = bfhi(v.x); up[2] = bflo(v.y); up[3] = bfhi(v.y); up[4] = bflo(v.z); up[5] = bfhi(v.z); up[6] = bflo(v.w); up[7] = bfhi(v.w); } } }
    __syncthreads();
    { const int wsz = 2 << g, hw = wsz >> 1, ch = tid & 127, tg = tid >> 7;
      const LAS float* up = U + ch; const int t0 = tg * 16;
      float s = 0.f; for (int rr = t0 + 8 - hw; rr < t0 + 8 - hw + wsz; ++rr) s += up[rr * 132];
      for (int tt = 0; tt < 16; ++tt) { const int t = t0 + tt, grow = R0 + t; const int lo = max(grow - hw, S0), hi = min(grow + wsz - 1 - hw, S1 - 1);
          const float pooled = s / (float)(hi - lo + 1) - up[(t + 8) * 132];
          P[t * 136 + ch] = (bf16_t)(pk2(pooled, 0.f) & 0xffffu);
          s += up[(t + 8 - hw + wsz) * 132] - up[(t + 8 - hw) * 132]; } }
    __syncthreads();
    f32x4 acc[4];
#pragma unroll
    for (int tb = 0; tb < 4; ++tb) acc[tb] = (f32x4){0.f, 0.f, 0.f, 0.f};
    const bf16_t* wp = cwT + ((size_t)g * 128 + 16 * w + l15) * 128 + 8 * quad;
#pragma unroll
    for (int kc = 0; kc < 4; ++kc) { const bf16x8 a = *(const GAS bf16x8*)(wp + 32 * kc);
#pragma unroll
        for (int tb = 0; tb < 4; ++tb) { const bf16x8 bb = *(const LAS bf16x8*)(P + (16 * tb + l15) * 136 + 32 * kc + 8 * quad);
            acc[tb] = __builtin_amdgcn_mfma_f32_16x16x32_bf16(a, bb, acc[tb], 0, 0, 0); } }
    const int e0 = 128 * g + 16 * w + 4 * quad; const f32x4 sc = *(const GAS f32x4*)(cscale + e0);
#pragma unroll
    for (int tb = 0; tb < 4; ++tb) { const f32x4 v = acc[tb] * sc; u32x2 wv; wv.x = pk2(v[0], v[1]); wv.y = pk2(v[2], v[3]);
        *(GAS u32x2*)(Y + (size_t)(R0 + 16 * tb + l15) * DM + 1024 + e0) = wv; }
}

#ifndef UDUP
#define UDUP 0
#endif
#ifndef UMASK
#define UMASK 15
#endif
#ifndef PMASK
#define PMASK 1023
#endif
DI void phase_mixers(const Ctx& C, int l, bool last) {
    unsigned char* ws = ARGWS(C);
    const bf16_t* Z = (const bf16_t*)(ws + WS_Z); bf16_t* Y = (bf16_t*)(ws + WS_Y);
    const float* misc = (const float*)(ws + WS_MISC);
    const float lam = misc[l], post = misc[2 + l], mA = misc[8 + 4 * l], mB = misc[9 + 4 * l], mD = misc[10 + 4 * l];
    const float* sink = ARGP(C, 11) + l * 8; const float* rpb = ARGP(C, 12) + (size_t)l * 8 * 15 * 31; const float* subln = ARGP(C, 16) + l * 128;
    const bf16_t* cwT = (const bf16_t*)(ws + WS_CWT) + (size_t)l * 4 * 128 * 128; const float* cscale = ARGP(C, 14) + l * 512;
    const int nC = last ? (NLAT / 64) * 4 : (MROWS / 64) * 4;
    for (int rep = 0; rep < ((UDUP & 1) ? 2 : 1); ++rep)
    if (UMASK & 1) for (int u = C.bid; u < 256; u += C.G) { const int b = u >> 6, qb = (u >> 2) & 15, h = u & 3; attn_unit_d32(C, Z, Y, b, qb, h, false, lam, post, subln, mD); }
    for (int rep = 0; rep < ((UDUP & 2) ? 2 : 1); ++rep)
    if (UMASK & 2) for (int u = C.bid; u < 256; u += C.G) { const int b = u >> 6, qb = (u >> 1) & 31, g = u & 1; attn_unit<0>(C, Z, Y, b, qb, g, false, sink, nullptr, 0.f, 0.f, nullptr, mA); }
    for (int rep = 0; rep < ((UDUP & 4) ? 2 : 1); ++rep)
    if (UMASK & 4) for (int u = C.bid; u < 512; u += C.G) { const int b = u >> 7, rp = (u >> 3) & 15, h = u & 7; attn_unit<1>(C, Z, Y, b, rp, h, false, nullptr, rpb + h * 15 * 31, 0.f, 0.f, nullptr, mB); }
    for (int rep = 0; rep < ((UDUP & 8) ? 2 : 1); ++rep)
    if (UMASK & 8) for (int u = C.bid; u < nC; u += C.G) pool_unit(C, Z, Y, cwT, cscale, u >> 2, u & 3);
    if (!last) {
        const int rb = C.G - 1 - C.bid;
        if (UMASK & 2) for (int u = rb; u < 32; u += C.G) { const int b = u >> 3, qb = (u >> 1) & 3, g = u & 1; attn_unit<0>(C, Z, Y, b, qb, g, true, sink, nullptr, 0.f, 0.f, nullptr, mA); }
        if (UMASK & 4) for (int u = rb - 32; u < 64; u += C.G) { if (u >= 0) { const int b = u >> 4, hq = (u >> 3) & 1, h = u & 7; attn_unit<1>(C, Z, Y, b, hq, h, true, nullptr, nullptr, 0.f, 0.f, nullptr, mB); } }
        if (UMASK & 1) for (int u = rb - 96; u < 32; u += C.G) { if (u >= 0) { const int b = u >> 3, hq = (u >> 2) & 1, h = u & 3; attn_unit_d32(C, Z, Y, b, hq, h, true, lam, post, subln, mD); } }
    }
}

constexpr int N_PHASES = 19;

#define XB_TMO      128
#define XB_XCNT(j)  (256  + 64 * (j))
#define XB_XSUB(j)  (1280 + 64 * (j))
#define XB_XGEN(j)  (2304 + 64 * (j))
#define XB_TOP      3328
#define XB_TOPGEN   3392
#define XCD_BAR_WORDS 3456
#define XB_SPIN_CAP (1u << 18)
DI unsigned xb_ld(unsigned* p)              { return __hip_atomic_load(p, __ATOMIC_RELAXED, __HIP_MEMORY_SCOPE_AGENT); }
DI unsigned xb_add(unsigned* p, unsigned v) { return __hip_atomic_fetch_add(p, v, __ATOMIC_RELAXED, __HIP_MEMORY_SCOPE_AGENT); }
DI unsigned xb_xcc_id() { return (unsigned)__builtin_amdgcn_s_getreg((3 << 11) | 20) & 0xFu; }
#define XB_SPIN(cond, bar) do { unsigned _sp = 0; while (cond) { __builtin_amdgcn_s_sleep(1); \
    if ((++_sp & 255u) == 0u) { if (xb_ld(&(bar)[XB_TMO])) break; if (_sp > XB_SPIN_CAP) { atomicAdd(&(bar)[XB_TMO], 1u); break; } } } } while (0)
DI void xcd_barrier_complete(unsigned* bar, unsigned x, unsigned G, unsigned& nloc, unsigned& nx) {
    unsigned sum, cnt, mine, sp = 0u;
    for (;;) {
        sum = 0u; cnt = 0u; mine = 0u;
#pragma unroll
        for (unsigned j = 0; j < 16; ++j) { const unsigned c = xb_ld(&bar[XB_XCNT(j)]); sum += c; cnt += (c > 0u) ? 1u : 0u; mine = (j == x) ? c : mine; }
        if (sum == G) break;
        __builtin_amdgcn_s_sleep(1);
        if ((++sp & 255u) == 0u) { if (xb_ld(&bar[XB_TMO])) break; if (sp > XB_SPIN_CAP) { atomicAdd(&bar[XB_TMO], 1u); break; } }
    }
    nloc = mine > 0u ? mine : 1u; nx = cnt > 0u ? cnt : 1u;
}
DI void grid_barrier(const Ctx& C, unsigned* bar, volatile LAS unsigned* st) {
    asm volatile("s_waitcnt vmcnt(0)" ::: "memory");
    __syncthreads();
    if (C.tid == 0) {
        const unsigned x = xb_xcc_id();
        __builtin_amdgcn_s_waitcnt(0);
        unsigned nloc = st[0], nx = st[1];
        if (nloc == 0u) { xcd_barrier_complete(bar, x, (unsigned)C.G, nloc, nx); st[0] = nloc; st[1] = nx; }
        const unsigned old = xb_add(&bar[XB_XSUB(x)], 1u);
        const unsigned gen = old / nloc;
        if (old + 1u == (gen + 1u) * nloc) {
            __builtin_amdgcn_fence(__ATOMIC_RELEASE, "agent");
            asm volatile("s_waitcnt vmcnt(0)" ::: "memory");
            const unsigned og = xb_add(&bar[XB_TOP], 1u);
            const unsigned tg = og / nx;
            if (og + 1u == (tg + 1u) * nx) xb_add(&bar[XB_TOPGEN], 1u);
            else XB_SPIN(xb_ld(&bar[XB_TOPGEN]) == tg, bar);
            __builtin_amdgcn_fence(__ATOMIC_ACQUIRE, "agent");
            xb_add(&bar[XB_XGEN(x)], 1u);
            asm volatile("s_waitcnt vmcnt(0)" ::: "memory");
        } else {
            XB_SPIN(xb_ld(&bar[XB_XGEN(x)]) == gen, bar);
            __builtin_amdgcn_fence(__ATOMIC_ACQUIRE, "agent");
            asm volatile("s_waitcnt vmcnt(0)" ::: "memory");
        }
    }
    __syncthreads();
}

__global__ void __launch_bounds__(NTHREADS, 2) fwd_kernel(Args A) {
    extern __shared__ __attribute__((aligned(16))) unsigned char lds_raw[];
    if (A.ph_hi < 0) cg::this_grid().sync();
    const int wave_s = __builtin_amdgcn_readfirstlane((int)threadIdx.x >> 6);
    Ctx C; C.lds = (LAS unsigned char*)lds_raw; C.tid = threadIdx.x; C.lane = C.tid & 63; C.wave = wave_s; C.G = gridDim.x; C.bid = blockIdx.x;
#define REFRESH_CTX() do { int l_, w_ = wave_s, b_ = blockIdx.x, g_ = gridDim.x; \
        asm volatile("v_mbcnt_lo_u32_b32 %0, -1, 0\n\tv_mbcnt_hi_u32_b32 %0, -1, %0" : "=v"(l_)); asm volatile("" : "+s"(w_), "+s"(b_), "+s"(g_)); \
        C.tid = w_ * 64 + l_; C.lane = l_; C.wave = w_; C.G = g_; C.bid = b_; } while (0)
    { LAS unsigned long long* lp = (LAS unsigned long long*)(C.lds + ARG_OFF);
      if (C.tid == 0) {
#pragma unroll
          for (int i = 0; i < 21; ++i) lp[i] = (unsigned long long)A.in[i];
          lp[21] = (unsigned long long)A.out; lp[22] = (unsigned long long)A.ws;
          volatile LAS unsigned* st = (volatile LAS unsigned*)(C.lds + ARG_OFF + 512); st[0] = 0u; st[1] = 0u;
          if (A.ph_hi - A.ph_lo > 1) (void)xb_add((unsigned*)(A.ws + WS_BAR) + XB_XCNT(xb_xcc_id()), 1u); }
      __syncthreads(); }
    const int ph_lo = A.ph_lo, ph_hi = A.ph_hi;
    for (int ph = ph_lo; ph < ph_hi; ++ph) {
        REFRESH_CTX();
        if (ph > ph_lo) grid_barrier(C, (unsigned*)(ARGWS(C) + WS_BAR), (volatile LAS unsigned*)(C.lds + ARG_OFF + 512));
#ifndef PROBE_K
#define PROBE_K 100
#endif
        if (ph == 0) { if (PMASK & 512) { phase_prep(C); if (PROBE_K == 9) phase_prep(C); } continue; }
        const int l = (ph - 1) / 9, k = (ph - 1) % 9; const bool last = (l == 1);
        const int Mx = last ? NLAT : MROWS;
        unsigned char* ws = ARGWS(C);
        const float* modl = (const float*)(ws + WS_MOD) + (size_t)l * 5 * MODW;
        const bf16_t* wl = (const bf16_t*)(ws + WS_WT) + (size_t)l * WT_LAYER;
        float* xs = (float*)(ws + WS_XS); bf16_t* H = (bf16_t*)(ws + WS_H);
        pg8::StaticOrder S;
        for (int rep = 0; rep < ((k == PROBE_K) ? 2 : 1); ++rep) { REFRESH_CTX();
        switch (k) {
        case 0: if (PMASK & 1) if (l == 0) phase_norm(C, ARGP(C, 0), ARGP(C, 2), H, ARGP(C, 6), modl, 0, DM, MROWS, nullptr, 0, nullptr);
                else phase_norm(C, xs, xs + (size_t)NLAT * DM, H, ARGP(C, 6) + l * DM, modl, 0, DM, MROWS, (const float*)(ws + WS_PB), KSPLIT, xs);
                break;
        case 1: if (PMASK & 2) { pg8::Gemm g{H, wl + WT_IN, MROWS, PROJ, DM, 0, 0}; S.init(MROWS, PROJ, C.G, C.bid); pg8::EpiIn E{(bf16_t*)(ws + WS_Z), (bf16_t*)(ws + WS_G), ARGP(C, 9) + (size_t)l * GW};
                  pg8::gemm_phase<pg8::EpiIn, true>(C.lds, C.tid, g, S, E); } break;
        case 2: if (PMASK & 4) phase_qknorm(C, (bf16_t*)(ws + WS_Z), ARGP(C, 10) + l * 384, (const float*)(ws + WS_ROPE), (const float*)(ws + WS_ROPE) + SEQ * 32); break;
        case 3: if (PMASK & 8) phase_mixers(C, l, last); break;
        case 4: if (PMASK & 16) { pg8::Gemm g{(const bf16_t*)(ws + WS_Y), wl + WT_BR, Mx, DM, DM, 0, 0}; const bool coop = (ph_hi - ph_lo > 1);
                  if (last) S.init(NLAT, DM, C.G, C.bid); else if (coop) S.init(NLAT, DM, C.G, C.bid, NCTX, 4); else S.init(MROWS, DM, C.G, C.bid);
                  pg8::EpiMerge E{(const bf16_t*)(ws + WS_G), (bf16_t*)(ws + WS_MB), (float*)(ws + WS_PB)};
                  pg8::gemm_phase<pg8::EpiMerge, true>(C.lds, C.tid, g, S, E);
                  if (!last && coop) {
                      grid_barrier(C, (unsigned*)(ws + WS_BAR), (volatile LAS unsigned*)(C.lds + ARG_OFF + 512));
                      const GAS f32x4* pb = (const GAS f32x4*)(ws + WS_PB); GAS u32x2* mb = (GAS u32x2*)((bf16_t*)(ws + WS_MB) + (size_t)NLAT * DM);
                      constexpr int NQ = NCTX * DM / 4;
                      const int i0 = C.bid * NTHREADS + C.tid, st = C.G * NTHREADS;
                      for (int ib = i0; ib < NQ; ib += 4 * st) { f32x4 t[4][4];
#pragma unroll
                          for (int q = 0; q < 4; ++q) { const int i = min(ib + q * st, NQ - 1);
#pragma unroll
                              for (int k = 0; k < 4; ++k) t[q][k] = pb[k * NQ + i]; }
#pragma unroll
                          for (int q = 0; q < 4; ++q) { const int i = ib + q * st; const f32x4 v = (t[q][0] + t[q][1]) + (t[q][2] + t[q][3]);
                              u32x2 w; w.x = pk2(v[0], v[1]); w.y = pk2(v[2], v[3]); if (i < NQ) mb[i] = w; } } } } break;
        case 5: if (PMASK & 32) { pg8::Gemm g{(const bf16_t*)(ws + WS_MB), wl + WT_OUT, Mx, DM, DM, 0, 0}; if (last) S.init(NLAT, DM, C.G, C.bid); else S.init(NLAT, DM, C.G, C.bid, NCTX, KSPLIT);
                  pg8::EpiRes E{last ? xs : ARGP(C, 0), last ? xs + (size_t)NLAT * DM : ARGP(C, 2), xs, modl + 2 * DM, (float*)(ws + WS_PB)};
                  pg8::gemm_phase<pg8::EpiRes, true>(C.lds, C.tid, g, S, E); } break;
        case 6: if (PMASK & 64) if (last) phase_norm(C, xs, xs + (size_t)NLAT * DM, H, ARGP(C, 7) + l * DM, modl, 3 * DM, 4 * DM, Mx, nullptr, 0, nullptr);
                else phase_norm(C, xs, ARGP(C, 2), H, ARGP(C, 7), modl, 3 * DM, 4 * DM, Mx, (const float*)(ws + WS_PB), KSPLIT, xs);
                break;
        case 7: if (PMASK & 128) { pg8::Gemm g{H, wl + WT_F1, Mx, DFF, DM, 0, 0}; S.init(Mx, DFF, C.G, C.bid); pg8::EpiSq E{(bf16_t*)(ws + WS_U), DFF};
                  pg8::gemm_phase<pg8::EpiSq, true>(C.lds, C.tid, g, S, E); } break;
        case 8: if (PMASK & 256) { pg8::Gemm g{(const bf16_t*)(ws + WS_U), wl + WT_F2, Mx, DM, DFF, MROWS, DM};        if (last) S.init(NLAT, DM, C.G, C.bid); else S.init(NLAT, DM, C.G, C.bid, NCTX, KSPLIT);
                  pg8::EpiRes E{xs, xs + (size_t)NLAT * DM, last ? (float*)ARGP(C, 21) : xs, modl + 5 * DM, (float*)(ws + WS_PB)};
                  pg8::gemm_phase<pg8::EpiRes, true>(C.lds, C.tid, g, S, E); } break;
        } }
    }
}

extern "C" void kernel_launch(void* const* d_in, const int* in_sizes, int n_in, void* d_out, int out_size, void* d_ws, size_t ws_size, hipStream_t stream) {
    static int grid = 0;
    if (grid == 0) {
        if (n_in != 21 || out_size != NLAT * DM || ws_size < WS_END) { fprintf(stderr, "kernel_launch: unexpected shapes (n_in %d, out %d, ws %zu); nothing launched\n", n_in, out_size, ws_size); grid = -1; return; }
        int dev = 0, cus = 0, per_cu = 0;
        if (hipGetDevice(&dev) != hipSuccess || hipDeviceGetAttribute(&cus, hipDeviceAttributeMultiprocessorCount, dev) != hipSuccess) { grid = -1; return; }
        if (hipFuncSetAttribute((const void*)fwd_kernel, hipFuncAttributeMaxDynamicSharedMemorySize, LDS_BYTES) != hipSuccess) { fprintf(stderr, "kernel_launch: hipFuncSetAttribute failed\n"); grid = -1; return; }
        if (hipOccupancyMaxActiveBlocksPerMultiprocessor(&per_cu, (const void*)fwd_kernel, NTHREADS, LDS_BYTES) != hipSuccess || per_cu < 1) { fprintf(stderr, "kernel_launch: occupancy query says %d blocks per CU\n", per_cu); per_cu = 1; }
        (void)hipGetLastError();
        grid = cus * per_cu;
        if (grid > 256) grid = 256;
    }
    if (grid < 0) return;
    Args a{};
    for (int i = 0; i < 21; ++i) a.in[i] = (const float*)d_in[i];
    a.out = (float*)d_out; a.ws = (unsigned char*)d_ws;
#if N_LAUNCH_MODE == 1
    a.ph_lo = 0; a.ph_hi = N_PHASES;
    if (hipMemsetAsync((char*)d_ws + WS_BAR, 0, 16384, stream) != hipSuccess) { fprintf(stderr, "kernel_launch: memset failed\n"); return; }
    void* args[] = {&a};
    hipError_t e = hipLaunchCooperativeKernel((const void*)fwd_kernel, dim3(grid), dim3(NTHREADS), args, LDS_BYTES, stream);
    if (e != hipSuccess) fprintf(stderr, "cooperative launch failed: %s (grid %d)\n", hipGetErrorString(e), grid);
#else
    for (int ph = 0; ph < N_PHASES; ++ph) { a.ph_lo = ph; a.ph_hi = ph + 1; hipLaunchKernelGGL(fwd_kernel, dim3(grid), dim3(NTHREADS), LDS_BYTES, stream, a); }
#endif
}
```

```cpp
#include <hip/hip_runtime.h>
#include <hip/hip_cooperative_groups.h>
#include <cstdio>
#include <cstdint>
namespace cg = cooperative_groups;

#define DI __device__ __forceinline__
#define LAS __attribute__((address_space(3)))
#define GAS __attribute__((address_space(1)))
typedef unsigned short bf16_t;
typedef short bf16x8 __attribute__((ext_vector_type(8)));
typedef float f32x4 __attribute__((ext_vector_type(4)));
typedef float f32x2 __attribute__((ext_vector_type(2)));
typedef unsigned u32x4 __attribute__((ext_vector_type(4)));
typedef unsigned u32x2 __attribute__((ext_vector_type(2)));
typedef __bf16 bf16x2_t __attribute__((ext_vector_type(2)));

#ifndef N_LAUNCH_MODE
#define N_LAUNCH_MODE 1
#endif

constexpr int DM = 2048, NBATCH = 4, SEQ = 2048, CTXL = 256, NLAT = NBATCH * SEQ, NCTX = NBATCH * CTXL, MROWS = NLAT + NCTX;
constexpr int PROJ = 12544, ZW = 4352, GW = 8192, DFF = 8192, MODW = 6 * DM;
constexpr int Z_AQ = 0, Z_AK = 512, Z_AV = 640, Z_BQ = 768, Z_BK = 1280, Z_BV = 1792, Z_CU = 2304, Z_DQ = 2816, Z_DK = 3328, Z_DV = 3840;
constexpr float EPS = 1e-6f, LOG2E = 1.4426950408889634f, QSCALE = 0.125f * LOG2E, NEGBIG = -1e30f;
constexpr int NTHREADS = 512, NWAVES = 8;

constexpr size_t MiB = 1u << 20;
constexpr size_t WS_MISC = 0;
constexpr size_t WS_BAR = 1536 * 1024;
constexpr size_t WS_MOD = 4096;
constexpr size_t WS_ROPE = 512 * 1024;
constexpr size_t WS_CWT = 1 * MiB;
constexpr size_t WS_WT = 2 * MiB;
constexpr size_t WT_IN = 0, WT_BR = (size_t)PROJ * DM, WT_OUT = WT_BR + (size_t)DM * DM, WT_F1 = WT_OUT + (size_t)DM * DM, WT_F2 = WT_F1 + (size_t)DFF * DM, WT_LAYER = WT_F2 + (size_t)DFF * DM;
constexpr size_t WS_XS = 260 * MiB;
constexpr size_t WS_H = 332 * MiB;
constexpr size_t WS_Y = 368 * MiB;
constexpr size_t WS_MB = 404 * MiB;
constexpr size_t WS_Z = 440 * MiB;
constexpr size_t WS_G = 517 * MiB;
constexpr size_t WS_U = 440 * MiB;
constexpr size_t WS_PB = 661 * MiB;
constexpr size_t WS_END = 725 * MiB;
constexpr int KSPLIT = 8;
static_assert(WS_WT + 2 * WT_LAYER * 2 <= WS_XS, "weights fit");
static_assert(WS_Z + (size_t)MROWS * ZW * 2 <= WS_G && WS_G + (size_t)MROWS * GW * 2 <= WS_END && WS_U + (size_t)MROWS * DFF * 2 <= WS_END, "ws map");

constexpr int LDS_BYTES = 131072 + 1024;

DI unsigned pk2(float lo, float hi) { f32x2 v = {lo, hi}; bf16x2_t b = __builtin_convertvector(v, bf16x2_t); return __builtin_bit_cast(unsigned, b); }
DI float bflo(unsigned u) { return __uint_as_float(u << 16); }
DI float bfhi(unsigned u) { return __uint_as_float(u & 0xffff0000u); }
DI float shx(float v, int m, int lane) { return __builtin_bit_cast(float, __builtin_amdgcn_ds_bpermute((lane ^ m) << 2, __builtin_bit_cast(int, v))); }
DI float wave_sum(float v, int lane) {
#pragma unroll
    for (int o = 1; o < 64; o <<= 1) v += shx(v, o, lane);
    return v;
}
DI float fast_exp2(float x) { return __builtin_amdgcn_exp2f(x); }
DI float fast_rcp(float x) { return __builtin_amdgcn_rcpf(x); }

namespace pg8 {
constexpr int BM = 256, BK = 64, HALF = 128, HTB = HALF * BK * 2, STAGE_BYTES = 8 * HTB, NXCD = 8, WGM = 8;
__host__ __device__ __forceinline__ int lds_byte(int r, int c) { const int st = (r >> 4) * 2 + (c >> 5), rr = r & 15, cc = c & 31, ob = rr * 64 + cc * 2; return st * 1024 + (ob ^ (((ob >> 9) & 1) << 5)); }
__host__ __device__ __forceinline__ void stage_rc(int b, int& R, int& C) { const int st = b / 1024, sb = b % 1024, swz = sb ^ (((sb >> 9) & 1) << 5); R = (st >> 1) * 16 + swz / 64; C = (st & 1) * 32 + (swz % 64) / 2; }
__host__ __device__ __forceinline__ int perm32(int rho) { const int n = rho >> 4, i = rho & 15; return 8 * (i >> 2) + 4 * n + (i & 3); }

struct Unit { int pm, pn, ks; };
struct Gemm { const bf16_t* A; const bf16_t* Bt; int M, N, K; int rowsA, rowsB; };

struct StaticOrder {
    int nM, nN, nwg, G, c, nsplit, nM2;
    __device__ void init(int M, int N, int G_, int c_, int M2 = 0, int nsplit_ = 0) { nM = M / BM; nN = N / BM; nwg = nM * nN; G = G_; c = c_; nsplit = nsplit_; nM2 = M2 / BM; }
    __device__ bool next(int i, Unit& u) const {
        const long L = (long)i * G + c;
        if (L >= nwg) { const long j = L - nwg; if (j >= (long)nM2 * nN * nsplit) return false;
            const int jj = (int)j; u.ks = jj % nsplit; const int tl = jj / nsplit; u.pn = tl % nN; u.pm = nM + tl / nN; return true; }
        u.ks = -1;
        int wgid = (int)L; { const int q = nwg / NXCD, r = nwg % NXCD, xcd = wgid % NXCD, off = wgid / NXCD; wgid = (xcd < r ? xcd * (q + 1) : r * (q + 1) + (xcd - r) * q) + off; }
        const int nig = WGM * nN, gid = wgid / nig, fm = gid * WGM, gsz = (nM - fm) < WGM ? (nM - fm) : WGM;
        u.pm = fm + ((wgid % nig) % gsz); u.pn = (wgid % nig) / gsz; return true;
    }
};

template <class Epi, bool ALIGN_EPI>
__device__ __forceinline__ void gemm_phase(LAS unsigned char* lds, const int tid, const Gemm g, const StaticOrder& S, const Epi& E) {
    const int wid = __builtin_amdgcn_readfirstlane(tid >> 6), lane = tid & 63, wr = wid >> 2, wc = wid & 3, fr = lane & 15, fq = lane >> 4;
    const int K = g.K, nt_full = K / BK, nt_split = S.nsplit > 0 ? nt_full / S.nsplit : nt_full;
    const unsigned rsA = g.rowsA > 0 ? 128u : (unsigned)K * 2u, rsB = g.rowsB > 0 ? 128u : (unsigned)K * 2u;
    const size_t kstepA = g.rowsA > 0 ? (size_t)g.rowsA * 128 : (size_t)(BK * 2), kstepB = g.rowsB > 0 ? (size_t)g.rowsB * 128 : (size_t)(BK * 2);
    unsigned voffA[2], voffB[2];
#pragma unroll
    for (int i = 0; i < 2; ++i) { int R, C; stage_rc(tid * 16 + i * 8192, R, C); const int Rb = Epi::PERM ? ((R & ~31) + perm32(R & 31)) : R;
        voffA[i] = (unsigned)R * rsA + (unsigned)C * 2u; voffB[i] = (unsigned)Rb * rsB + (unsigned)C * 2u; }
    const size_t hstepA = (size_t)HALF * rsA, hstepB = (size_t)HALF * rsB;
    const size_t tstepA = 2 * hstepA, tstepB = 2 * hstepB;
    const unsigned ldsw = (unsigned)wid * 1024u;
    const int aoff = lds_byte(wr * 64 + fr, fq * 8), boff = lds_byte(wc * 32 + fr, fq * 8);
#define PG8_SA(b, h) (((b) * 2 + (h)) * HTB)
#define PG8_SB(b, h) ((4 + (b) * 2 + (h)) * HTB)
#define PG8_STAGE(bufoff, gbase, voff) do { _Pragma("unroll") for (int _i = 0; _i < 2; ++_i) \
        __builtin_amdgcn_global_load_lds((const unsigned*)((const char*)(gbase) + (voff)[_i]), (LAS unsigned*)(lds + (bufoff) + ldsw + _i * 8192), 16, 0, 0); } while (0)
#define PG8_LDA(dst, b, h) do { _Pragma("unroll") for (int m = 0; m < 4; ++m) _Pragma("unroll") for (int k = 0; k < 2; ++k) dst[m][k] = *(const LAS bf16x8*)(lds + PG8_SA(b, h) + aoff + m * 2048 + k * 1024); } while (0)
#define PG8_LDB(dst, b, h) do { _Pragma("unroll") for (int n = 0; n < 2; ++n) _Pragma("unroll") for (int k = 0; k < 2; ++k) dst[n][k] = *(const LAS bf16x8*)(lds + PG8_SB(b, h) + boff + n * 2048 + k * 1024); } while (0)
#define PG8_MMA(ai, bj, At, Bt) do { __builtin_amdgcn_s_setprio(1); _Pragma("unroll") for (int m = 0; m < 4; ++m) _Pragma("unroll") for (int n = 0; n < 2; ++n) _Pragma("unroll") for (int k = 0; k < 2; ++k) \
        acc[ai][bj][m][n] = __builtin_amdgcn_mfma_f32_16x16x32_bf16(Bt[n][k], At[m][k], acc[ai][bj][m][n], 0, 0, 0); __builtin_amdgcn_s_setprio(0); } while (0)
#define PG8_WAIT_V(n) asm volatile("s_waitcnt vmcnt(" #n ")" ::: "memory")
#define PG8_WAIT_L(n) asm volatile("s_waitcnt lgkmcnt(" #n ")" ::: "memory")
#define PG8_BAR __builtin_amdgcn_s_barrier()
#define PG8_SCHED __builtin_amdgcn_sched_barrier(0)
    Unit cur, nxt; int ui = 0;
    if (!S.next(0, cur)) return;
    f32x4 acc[2][2][4][2];
#pragma unroll
    for (int a = 0; a < 2; ++a)
#pragma unroll
        for (int b = 0; b < 2; ++b)
#pragma unroll
            for (int m = 0; m < 4; ++m)
#pragma unroll
                for (int n = 0; n < 2; ++n) acc[a][b][m][n] = (f32x4){0.f, 0.f, 0.f, 0.f};
    bf16x8 At[4][2], B0[2][2], B1[2][2];
#define PG8_KOFFA(u) ((u).ks >= 0 ? (size_t)(u).ks * nt_split * kstepA : (size_t)0)
#define PG8_KOFFB(u) ((u).ks >= 0 ? (size_t)(u).ks * nt_split * kstepB : (size_t)0)
    const char* cA = (const char*)g.A + (size_t)cur.pm * tstepA + PG8_KOFFA(cur); const char* cB = (const char*)g.Bt + (size_t)cur.pn * tstepB + PG8_KOFFB(cur);
    PG8_STAGE(PG8_SB(0, 0), cB, voffB); PG8_STAGE(PG8_SB(0, 1), cB + hstepB, voffB); PG8_STAGE(PG8_SA(0, 0), cA, voffA); PG8_STAGE(PG8_SA(0, 1), cA + hstepA, voffA);
    if (wr == 1) PG8_BAR;
    PG8_WAIT_V(2); PG8_BAR;
    PG8_STAGE(PG8_SB(1, 0), cB + kstepB, voffB); PG8_STAGE(PG8_SA(1, 0), cA + kstepA, voffA); PG8_STAGE(PG8_SB(1, 1), cB + hstepB + kstepB, voffB);
    PG8_WAIT_V(6); PG8_BAR;
    for (;;) {
        const bool has_next = S.next(ui + 1, nxt);
        const char* nA = has_next ? (const char*)g.A + (size_t)nxt.pm * tstepA + PG8_KOFFA(nxt) : cA; const char* nB = has_next ? (const char*)g.Bt + (size_t)nxt.pn * tstepB + PG8_KOFFB(nxt) : cB;
        const int nt = cur.ks >= 0 ? nt_split : nt_full;
        for (int t = 0; t < nt; t += 2) {
            if constexpr (Epi::HOOK) { if (t != 0 && (t & 7) == 0) E.hook(acc, cur, (t >> 3) - 1, wr, wc, fr, fq); }
            const bool last = (t == nt - 2);
            const char* a1 = cA + (size_t)(t + 1) * kstepA;
            const char* a2 = last ? nA : cA + (size_t)(t + 2) * kstepA; const char* b2 = last ? nB : cB + (size_t)(t + 2) * kstepB;
            const char* a3 = a2 + kstepA; const char* b3 = b2 + kstepB;
            PG8_LDB(B0, 0, 0); PG8_LDB(B1, 0, 1); PG8_SCHED; PG8_LDA(At, 0, 0); PG8_STAGE(PG8_SA(1, 1), a1 + hstepA, voffA);
            PG8_WAIT_V(8); PG8_WAIT_L(0); PG8_BAR; PG8_MMA(0, 0, At, B0); PG8_MMA(0, 1, At, B1); PG8_BAR; PG8_SCHED;
            PG8_LDA(At, 0, 1); PG8_STAGE(PG8_SB(0, 0), b2, voffB); PG8_STAGE(PG8_SB(0, 1), b2 + hstepB, voffB); PG8_STAGE(PG8_SA(0, 0), a2, voffA);
            PG8_WAIT_V(8); PG8_WAIT_L(0); PG8_BAR; PG8_MMA(1, 0, At, B0); PG8_MMA(1, 1, At, B1); PG8_BAR; PG8_SCHED;
            PG8_LDB(B0, 1, 0); PG8_LDB(B1, 1, 1); PG8_SCHED; PG8_LDA(At, 1, 0); PG8_STAGE(PG8_SA(0, 1), a2 + hstepA, voffA);
            PG8_WAIT_V(8); PG8_WAIT_L(0); PG8_BAR; PG8_MMA(0, 0, At, B0); PG8_MMA(0, 1, At, B1); PG8_BAR; PG8_SCHED;
            PG8_LDA(At, 1, 1); PG8_STAGE(PG8_SB(1, 0), b3, voffB); PG8_STAGE(PG8_SB(1, 1), b3 + hstepB, voffB); PG8_STAGE(PG8_SA(1, 0), a3, voffA);
            PG8_WAIT_V(8); PG8_WAIT_L(0); PG8_BAR; PG8_MMA(1, 0, At, B0); PG8_MMA(1, 1, At, B1); PG8_BAR; PG8_SCHED;
        }
        if constexpr (ALIGN_EPI) { if (wr == 0) PG8_BAR; }
        E(acc, cur, wr, wc, fr, fq);
        if (!has_next) break;
#pragma unroll
        for (int a = 0; a < 2; ++a)
#pragma unroll
            for (int b = 0; b < 2; ++b)
#pragma unroll
                for (int m = 0; m < 4; ++m)
#pragma unroll
                    for (int n = 0; n < 2; ++n) acc[a][b][m][n] = (f32x4){0.f, 0.f, 0.f, 0.f};
        cur = nxt; cA = nA; cB = nB; ++ui;
        if constexpr (ALIGN_EPI) { if (wr == 1) PG8_BAR; }
    }
    PG8_WAIT_V(0);
    if constexpr (!ALIGN_EPI) { if (wr == 0) PG8_BAR; }
    PG8_BAR;
#undef PG8_KOFFA
#undef PG8_KOFFB
#undef PG8_SA
#undef PG8_SB
#undef PG8_STAGE
#undef PG8_LDA
#undef PG8_LDB
#undef PG8_MMA
#undef PG8_WAIT_V
#undef PG8_WAIT_L
#undef PG8_BAR
#undef PG8_SCHED
}

struct EpiIn {
    static constexpr bool PERM = true, HOOK = false;
    bf16_t* Zp; bf16_t* Gp; const float* bgate;
    __device__ __forceinline__ void hook(f32x4 (&)[2][2][4][2], const Unit&, int, int, int, int, int) const {}
    __device__ __forceinline__ void operator()(const f32x4 (&acc)[2][2][4][2], const Unit& u, int wr, int wc, int fr, int fq) const {
        const int row0 = u.pm * BM + wr * 64 + fr; const int colt = u.pn * BM;
        if (colt < ZW) {
            const int col0 = colt + wc * 32 + 8 * fq;
#pragma unroll
            for (int ai = 0; ai < 2; ++ai)
#pragma unroll
                for (int m = 0; m < 4; ++m) { bf16_t* rowp = Zp + (size_t)(row0 + ai * HALF + m * 16) * ZW + col0;
#pragma unroll
                    for (int bj = 0; bj < 2; ++bj) { const f32x4 v0 = acc[ai][bj][m][0], v1 = acc[ai][bj][m][1];
                        u32x4 w; w.x = pk2(v0[0], v0[1]); w.y = pk2(v0[2], v0[3]); w.z = pk2(v1[0], v1[1]); w.w = pk2(v1[2], v1[3]);
                        *(GAS u32x4*)(rowp + bj * HALF) = w; } }
        } else {
            const int col0 = colt - ZW + wc * 32 + 8 * fq;
            f32x4 bv[2][2];
#pragma unroll
            for (int bj = 0; bj < 2; ++bj)
#pragma unroll
                for (int n = 0; n < 2; ++n) bv[bj][n] = *(const GAS f32x4*)(bgate + col0 + bj * HALF + 4 * n);
#pragma unroll
            for (int ai = 0; ai < 2; ++ai)
#pragma unroll
                for (int m = 0; m < 4; ++m) { bf16_t* rowp = Gp + (size_t)(row0 + ai * HALF + m * 16) * GW + col0;
#pragma unroll
                    for (int bj = 0; bj < 2; ++bj) { f32x4 v0 = acc[ai][bj][m][0] + bv[bj][0], v1 = acc[ai][bj][m][1] + bv[bj][1];
#pragma unroll
                        for (int e = 0; e < 4; ++e) { float a = fminf(fmaxf(v0[e], -30.f), 30.f), b = fminf(fmaxf(v1[e], -30.f), 30.f);
                            v0[e] = fast_rcp(1.f + fast_exp2(-a * LOG2E)); v1[e] = fast_rcp(1.f + fast_exp2(-b * LOG2E)); }
                        u32x4 w; w.x = pk2(v0[0], v0[1]); w.y = pk2(v0[2], v0[3]); w.z = pk2(v1[0], v1[1]); w.w = pk2(v1[2], v1[3]);
                        *(GAS u32x4*)(rowp + bj * HALF) = w; } }
        }
    }
};
struct EpiSq {
    static constexpr bool PERM = true, HOOK = false;
    bf16_t* O; int ldc;
    __device__ __forceinline__ void hook(f32x4 (&)[2][2][4][2], const Unit&, int, int, int, int, int) const {}
    __device__ __forceinline__ void operator()(const f32x4 (&acc)[2][2][4][2], const Unit& u, int wr, int wc, int fr, int fq) const {
        const int row0 = u.pm * BM + wr * 64 + fr;
#pragma unroll
        for (int ai = 0; ai < 2; ++ai)
#pragma unroll
            for (int m = 0; m < 4; ++m) { const int row = row0 + ai * HALF + m * 16;
#pragma unroll
                for (int bj = 0; bj < 2; ++bj) { f32x4 v0 = acc[ai][bj][m][0], v1 = acc[ai][bj][m][1];
#pragma unroll
                    for (int e = 0; e < 4; ++e) { const float a = fmaxf(v0[e], 0.f), b = fmaxf(v1[e], 0.f); v0[e] = a * a; v1[e] = b * b; }
                    u32x4 w; w.x = pk2(v0[0], v0[1]); w.y = pk2(v0[2], v0[3]); w.z = pk2(v1[0], v1[1]); w.w = pk2(v1[2], v1[3]);
                    const int kblk = u.pn * 4 + bj * 2 + (wc >> 1);
                    *(GAS u32x4*)(O + ((size_t)kblk * MROWS + row) * 64 + 32 * (wc & 1) + 8 * fq) = w; } }
    }
};
struct EpiMerge {
    static constexpr bool PERM = true, HOOK = true;
    const bf16_t* Gp; bf16_t* O; float* part;
    __device__ __forceinline__ void hook(f32x4 (&acc)[2][2][4][2], const Unit& u, int k, int wr, int wc, int fr, int fq) const {
        int row0 = u.pm * BM + wr * 64 + fr; int col0 = u.pn * BM + wc * 32 + 8 * fq;
        asm volatile("" : "+v"(row0), "+v"(col0));
#pragma unroll
        for (int ai = 0; ai < 2; ++ai) {
            u32x4 ga[4][2], gb[4][2];
#pragma unroll
            for (int m = 0; m < 4; ++m) { const bf16_t* gp = Gp + (size_t)(row0 + ai * HALF + m * 16) * GW + k * DM + col0;
#pragma unroll
                for (int bj = 0; bj < 2; ++bj) { ga[m][bj] = *(const GAS u32x4*)(gp + bj * HALF); gb[m][bj] = *(const GAS u32x4*)(gp + DM + bj * HALF); } }
#pragma unroll
            for (int m = 0; m < 4; ++m)
#pragma unroll
                for (int bj = 0; bj < 2; ++bj) { const u32x4 a = ga[m][bj], b = gb[m][bj];
                    f32x4 r0, r1;
                    r0[0] = bflo(a.x) * fast_rcp(bflo(b.x)); r0[1] = bfhi(a.x) * fast_rcp(bfhi(b.x)); r0[2] = bflo(a.y) * fast_rcp(bflo(b.y)); r0[3] = bfhi(a.y) * fast_rcp(bfhi(b.y));
                    r1[0] = bflo(a.z) * fast_rcp(bflo(b.z)); r1[1] = bfhi(a.z) * fast_rcp(bfhi(b.z)); r1[2] = bflo(a.w) * fast_rcp(bflo(b.w)); r1[3] = bfhi(a.w) * fast_rcp(bfhi(b.w));
                    acc[ai][bj][m][0] *= r0; acc[ai][bj][m][1] *= r1; }
            asm volatile("" ::: "memory");
        }
    }
    __device__ __forceinline__ void operator()(const f32x4 (&acc)[2][2][4][2], const Unit& u, int wr, int wc, int fr, int fq) const {
        const int row0 = u.pm * BM + wr * 64 + fr; const int col0 = u.pn * BM + wc * 32 + 8 * fq;
        const int kg = u.ks >= 0 ? u.ks : 3;
#pragma unroll
        for (int ai = 0; ai < 2; ++ai) {
            u32x4 ga[4][2];
#pragma unroll
            for (int m = 0; m < 4; ++m) { const bf16_t* gp = Gp + (size_t)(row0 + ai * HALF + m * 16) * GW + kg * DM + col0;
#pragma unroll
                for (int bj = 0; bj < 2; ++bj) ga[m][bj] = *(const GAS u32x4*)(gp + bj * HALF); }
#pragma unroll
            for (int m = 0; m < 4; ++m) { bf16_t* rowp = O + (size_t)(row0 + ai * HALF + m * 16) * DM + col0;
                float* prow = part + ((size_t)(u.ks >= 0 ? u.ks : 0) * NCTX + (size_t)(row0 + ai * HALF + m * 16 - NLAT)) * DM + col0;
#pragma unroll
                for (int bj = 0; bj < 2; ++bj) { const u32x4 a = ga[m][bj]; const f32x4 v0 = acc[ai][bj][m][0], v1 = acc[ai][bj][m][1];
                    const f32x4 s0 = {v0[0] * bflo(a.x), v0[1] * bfhi(a.x), v0[2] * bflo(a.y), v0[3] * bfhi(a.y)}, s1 = {v1[0] * bflo(a.z), v1[1] * bfhi(a.z), v1[2] * bflo(a.w), v1[3] * bfhi(a.w)};
                    if (u.ks >= 0) { *(GAS f32x4*)(prow + bj * HALF) = s0; *(GAS f32x4*)(prow + bj * HALF + 4) = s1; }
                    else { u32x4 w; w.x = pk2(s0[0], s0[1]); w.y = pk2(s0[2], s0[3]); w.z = pk2(s1[0], s1[1]); w.w = pk2(s1[2], s1[3]);
                        *(GAS u32x4*)(rowp + bj * HALF) = w; } } }
            asm volatile("" ::: "memory");
        }
    }
};
struct EpiRes {
    static constexpr bool PERM = false, HOOK = false;
    const float* base_lat; const float* base_ctx; float* out; const float* gate; float* part;
    __device__ __forceinline__ void hook(f32x4 (&)[2][2][4][2], const Unit&, int, int, int, int, int) const {}
    __device__ __forceinline__ void operator()(const f32x4 (&acc)[2][2][4][2], const Unit& u, int wr, int wc, int fr, int fq) const {
        const int row0 = u.pm * BM + wr * 64 + fr; const int col0 = u.pn * BM + wc * 32 + 4 * fq;
        const int bslot = u.pm < 32 ? (u.pm >> 3) : 4;
        const float* gp = gate + (size_t)bslot * MODW + col0;
        if (u.ks >= 0) {
            float* pp = part + ((size_t)u.ks * NCTX + (row0 - NLAT)) * DM + col0;
#pragma unroll
            for (int bj = 0; bj < 2; ++bj)
#pragma unroll
                for (int n = 0; n < 2; ++n) { const f32x4 gv = *(const GAS f32x4*)(gp + bj * HALF + n * 16);
#pragma unroll
                    for (int ai = 0; ai < 2; ++ai)
#pragma unroll
                        for (int m = 0; m < 4; ++m) *(GAS f32x4*)(pp + (size_t)(ai * HALF + m * 16) * DM + bj * HALF + n * 16) = gv * acc[ai][bj][m][n]; }
            return;
        }
        const float* bp = (u.pm < 32 ? base_lat + (size_t)row0 * DM : base_ctx + (size_t)(row0 - NLAT) * DM) + col0;
        float* op = out + (size_t)row0 * DM + col0;
        f32x4 tb[1][8];
#define ERES_LOAD(q, bj, n) do { _Pragma("unroll") for (int ai = 0; ai < 2; ++ai) _Pragma("unroll") for (int m = 0; m < 4; ++m) \
            tb[q][ai * 4 + m] = *(const GAS f32x4*)(bp + (size_t)(ai * HALF + m * 16) * DM + (bj) * HALF + (n) * 16); } while (0)
#define ERES_STORE(q, bj, n) do { const f32x4 gv = *(const GAS f32x4*)(gp + (bj) * HALF + (n) * 16); \
            _Pragma("unroll") for (int ai = 0; ai < 2; ++ai) _Pragma("unroll") for (int m = 0; m < 4; ++m) \
                *(GAS f32x4*)(op + (size_t)(ai * HALF + m * 16) * DM + (bj) * HALF + (n) * 16) = tb[q][ai * 4 + m] + gv * acc[ai][bj][m][n]; } while (0)
#pragma unroll
        for (int bj = 0; bj < 2; ++bj)
#pragma unroll
            for (int n = 0; n < 2; ++n) { ERES_LOAD(0, bj, n); asm volatile("" ::: "memory"); ERES_STORE(0, bj, n); asm volatile("" ::: "memory"); }
#undef ERES_LOAD
#undef ERES_STORE
    }
};
}

struct Args { const float* in[21]; float* out; unsigned char* ws; int ph_lo, ph_hi; };

struct Ctx {
    LAS unsigned char* lds; int tid, lane, wave, G, bid;
};
constexpr int ARG_OFF = 131072;
DI const float* ARGP(const Ctx& C, int i) {
    volatile LAS unsigned* p = (volatile LAS unsigned*)(C.lds + ARG_OFF) + 2 * i;
    const unsigned lo = __builtin_amdgcn_readfirstlane(p[0]), hi = __builtin_amdgcn_readfirstlane(p[1]);
    return (const float*)(((unsigned long long)hi << 32) | (unsigned long long)lo);
}
DI unsigned char* ARGWS(const Ctx& C) { return (unsigned char*)ARGP(C, 22); }

struct TrItem { const float* W; bf16_t* WT; int K, N, item, tiled; };
DI void tr_load(const TrItem& T, int lane, f32x4 (&va)[8], f32x4 (&vb)[8]) {
    const int nblk = T.N / 64, kb = T.item / nblk, nb = T.item % nblk, k0 = 64 * kb, n0 = 64 * nb;
    const int nc = lane & 15, q = lane >> 4;
    const float* src = T.W + (size_t)(k0 + 2 * q) * T.N + n0 + 4 * nc;
#pragma unroll
    for (int i = 0; i < 8; ++i) { va[i] = __builtin_nontemporal_load((const GAS f32x4*)(src + (size_t)(8 * i) * T.N)); vb[i] = __builtin_nontemporal_load((const GAS f32x4*)(src + (size_t)(8 * i + 1) * T.N)); }
}
DI void tr_finish(const TrItem& T, int lane, const f32x4 (&va)[8], const f32x4 (&vb)[8], LAS unsigned char* scr) {
    const int nblk = T.N / 64, kb = T.item / nblk, nb = T.item % nblk, k0 = 64 * kb, n0 = 64 * nb;
    const int nc = lane & 15, q = lane >> 4;
#pragma unroll
    for (int i = 0; i < 8; ++i)
#pragma unroll
        for (int e = 0; e < 4; ++e) *(LAS unsigned*)(scr + (4 * nc + e) * 128 + ((i ^ (nc & 7)) * 16) + q * 4) = pk2(va[i][e], vb[i][e]);
    asm volatile("s_waitcnt lgkmcnt(0)" ::: "memory");
    const int c = lane & 7;
#pragma unroll
    for (int j = 0; j < 8; ++j) { const int n = (lane >> 3) + 8 * j; const u32x4 o = *(const LAS u32x4*)(scr + n * 128 + ((c ^ ((n >> 2) & 7)) * 16));
        bf16_t* dst = T.tiled ? T.WT + ((size_t)kb * T.N + n0 + n) * 64 + 8 * c : T.WT + (size_t)(n0 + n) * T.K + k0 + 8 * c;
        *(GAS u32x4*)dst = o; }
    asm volatile("s_waitcnt lgkmcnt(0)" ::: "memory");
}

DI void phase_prep(const Ctx& C) {
    unsigned char* ws = ARGWS(C);
    const int tid = C.tid, lane = C.lane, wave = C.wave;
    {
        LAS float* sl = (LAS float*)(C.lds + 73728);
        LAS float* red = (LAS float*)(C.lds + 73728 + 40960);
        const float* cin = ARGP(C, 1); const float* cctx = ARGP(C, 3);
        { float cvv[5 * DM / NTHREADS];
#pragma unroll
          for (int k = 0; k < 5 * DM / NTHREADS; ++k) { const int i = tid + k * NTHREADS, b = i >> 11, kk = i & 2047; cvv[k] = b < 4 ? cin[b * DM + kk] : cctx[kk]; }
#pragma unroll
          for (int k = 0; k < 5 * DM / NTHREADS; ++k) { const float cv = cvv[k]; sl[tid + k * NTHREADS] = cv / (1.f + __expf(-cv)); } }
        __syncthreads();
        float* mod = (float*)(ws + WS_MOD); const float* wada = ARGP(C, 4); const float* bada = ARGP(C, 5);
        for (int unit = C.bid; unit < 256; unit += C.G) {
            const int l = unit >> 7, j0 = (unit & 127) * 96, cl = lane & 31, ks = lane >> 5;
            f32x4 a0 = {0.f, 0.f, 0.f, 0.f}, a1 = a0, a2 = a0, a3 = a0, a4 = a0;
            if (cl < 24) {
                const int kb = wave * 256 + ks * 128;
                const float* wp = wada + ((size_t)l * DM + kb) * MODW + j0 + 4 * cl;
#pragma unroll 16
                for (int t = 0; t < 128; ++t) { const f32x4 wv = __builtin_nontemporal_load((const GAS f32x4*)(wp + (size_t)t * MODW));     const int k = kb + t;
                    a0 += sl[k] * wv; a1 += sl[DM + k] * wv; a2 += sl[2 * DM + k] * wv; a3 += sl[3 * DM + k] * wv; a4 += sl[4 * DM + k] * wv; }
            }
#pragma unroll
            for (int e = 0; e < 4; ++e) { a0[e] += shx(a0[e], 32, lane); a1[e] += shx(a1[e], 32, lane); a2[e] += shx(a2[e], 32, lane); a3[e] += shx(a3[e], 32, lane); a4[e] += shx(a4[e], 32, lane); }
            if (lane < 24) { LAS float* rp = red + (wave * 5) * 96 + 4 * lane;
                *(LAS f32x4*)(rp) = a0; *(LAS f32x4*)(rp + 96) = a1; *(LAS f32x4*)(rp + 192) = a2; *(LAS f32x4*)(rp + 288) = a3; *(LAS f32x4*)(rp + 384) = a4; }
            __syncthreads();
            if (tid < 480) { const int b = tid / 96, cc = tid % 96; float sm = 0.f;
#pragma unroll
                for (int w = 0; w < 8; ++w) sm += red[(w * 5 + b) * 96 + cc];
                mod[((size_t)l * 5 + b) * MODW + j0 + cc] = sm + bada[(size_t)l * MODW + j0 + cc]; }
            __syncthreads();
        }
    }
    const int gw = C.bid * NWAVES + wave, NGW = C.G * NWAVES;
    const int gt = C.bid * NTHREADS + tid, NGT = C.G * NTHREADS;
    {
        LAS unsigned char* scr = C.lds + wave * 8192;
        constexpr int I_IN = (DM / 64) * (PROJ / 64), I_SQ = (DM / 64) * (DM / 64), I_F1 = (DM / 64) * (DFF / 64), I_F2 = (DFF / 64) * (DM / 64);
        constexpr int I_LAYER = I_IN + 2 * I_SQ + I_F1 + I_F2;
        bf16_t* wt = (bf16_t*)(ws + WS_WT);
        const float* w_in = ARGP(C, 8); const float* w_br = ARGP(C, 17); const float* w_out = ARGP(C, 18); const float* w_f1 = ARGP(C, 19); const float* w_f2 = ARGP(C, 20);
#define TR_DECODE(it_, T_) do { const int l_ = (it_) / I_LAYER; int r_ = (it_) % I_LAYER; bf16_t* wl_ = wt + (size_t)l_ * WT_LAYER; \
            if (r_ < I_IN) { T_ = TrItem{w_in + (size_t)l_ * DM * PROJ, wl_ + WT_IN, DM, PROJ, r_, 0}; } \
            else if ((r_ -= I_IN) < I_SQ) { T_ = TrItem{w_br + (size_t)l_ * DM * DM, wl_ + WT_BR, DM, DM, r_, 0}; } \
            else if ((r_ -= I_SQ) < I_SQ) { T_ = TrItem{w_out + (size_t)l_ * DM * DM, wl_ + WT_OUT, DM, DM, r_, 0}; } \
            else if ((r_ -= I_SQ) < I_F1) { T_ = TrItem{w_f1 + (size_t)l_ * DM * DFF, wl_ + WT_F1, DM, DFF, r_, 0}; } \
            else { r_ -= I_F1; T_ = TrItem{w_f2 + (size_t)l_ * DFF * DM, wl_ + WT_F2, DFF, DM, r_, 1}; } } while (0)
        constexpr int NIT = 2 * I_LAYER;
        f32x4 a0[8], b0[8], a1[8], b1[8]; TrItem T0, T1;
        int it = gw;
        if (it < NIT) { TR_DECODE(it, T0); tr_load(T0, lane, a0, b0); }
        while (it < NIT) {
            const int it1 = it + NGW;
            if (it1 < NIT) { TR_DECODE(it1, T1); tr_load(T1, lane, a1, b1); }
            tr_finish(T0, lane, a0, b0, scr);
            if (it1 >= NIT) break;
            const int it2 = it1 + NGW;
            if (it2 < NIT) { TR_DECODE(it2, T0); tr_load(T0, lane, a0, b0); }
            tr_finish(T1, lane, a1, b1, scr);
            it = it2;
        }
#undef TR_DECODE
    }
    { bf16_t* cwt = (bf16_t*)(ws + WS_CWT); const float* cw = ARGP(C, 13);
      for (int i = gt; i < 2 * 4 * 128 * 128 / 2; i += NGT) { const int c = (i & 63) * 2, e = (i >> 6) & 127, lg = i >> 13;
          const float v0 = cw[((size_t)lg * 128 + c) * 128 + e], v1 = cw[((size_t)lg * 128 + c + 1) * 128 + e];
          *(GAS unsigned*)(cwt + ((size_t)lg * 128 + e) * 128 + c) = pk2(v0, v1); } }
    { float* rc = (float*)(ws + WS_ROPE); float* rs = rc + SEQ * 32;
      for (int i = gt; i < SEQ * 32; i += NGT) { const int t = i >> 5, j = i & 31; const float pos = (float)(j < 16 ? (t >> 6) : (t & 63)); const int f = j & 15;
          const float inv = exp2f(-(float)f * (13.287712379549449f / 16.f)); const float ang = pos * inv;
          const float n = rintf(ang * 0.15915494309189535f); float r = fmaf(-n, 6.28125f, ang); r = fmaf(-n, 0.0019353071795864769f, r);
          rc[i] = __cosf(r); rs[i] = __sinf(r); } }
    if (C.bid == 0 && wave == 0) {
        float* misc = (float*)(ws + WS_MISC); const float* qkg = ARGP(C, 10); const float* rpbp = ARGP(C, 12); const float* snk = ARGP(C, 11);
        for (int l = 0; l < 2; ++l) {
            float gm[6];
#pragma unroll
            for (int j = 0; j < 6; ++j) { float v = fabsf(qkg[l * 384 + j * 64 + lane]);
#pragma unroll
                for (int o = 1; o < 64; o <<= 1) v = fmaxf(v, shx(v, o, lane));
                gm[j] = v; }
            float rm = 0.f;
            { const GAS f32x4* rp4 = (const GAS f32x4*)(rpbp + l * 8 * 15 * 31);
#pragma unroll 8
              for (int i = lane; i < 930; i += 64) { const f32x4 v = rp4[i]; rm = fmaxf(fmaxf(rm, fmaxf(fabsf(v.x), fabsf(v.y))), fmaxf(fabsf(v.z), fabsf(v.w))); } }
            float sm = lane < 8 ? snk[l * 8 + lane] : -1e30f;
#pragma unroll
            for (int o = 1; o < 64; o <<= 1) { rm = fmaxf(rm, shx(rm, o, lane)); sm = fmaxf(sm, shx(sm, o, lane)); }
            if (lane == 0) { const float k = 64.f * QSCALE * 1.01f;
                misc[8 + 4 * l] = fmaxf(k * gm[0] * gm[1], sm * LOG2E); misc[9 + 4 * l] = k * gm[2] * gm[3] + rm * LOG2E; misc[10 + 4 * l] = k * gm[4] * gm[5]; }
        }
    }
    if (C.bid == 0 && tid < 2) { const int l = tid; const float* dl = ARGP(C, 15) + l * 256; float s1 = 0.f, s2 = 0.f;
        for (int i = 0; i < 64; ++i) { s1 += dl[i] * dl[64 + i]; s2 += dl[128 + i] * dl[192 + i]; }
        const float li = 0.8f - 0.6f * expf(-0.3f * (float)l); float* misc = (float*)(ws + WS_MISC);
        misc[l] = expf(s1) - expf(s2) + li; misc[2 + l] = 1.f - li; }
}

DI void phase_norm(const Ctx& C, const float* xlat, const float* xctx, bf16_t* H, const float* gn, const float* modl, int sh_off, int sc_off, int nrows, const float* part, int nsplit, float* xs_out) {
    const int gw = C.bid * NWAVES + C.wave, NGW = C.G * NWAVES, lane = C.lane;
    for (int row = gw; row < nrows; row += NGW) {
        const int b = row < NLAT ? (row >> 11) : 4;
        const float* mb = modl + (size_t)b * MODW;
        const GAS f32x4* xr = (const GAS f32x4*)(row < NLAT ? xlat + (size_t)row * DM : xctx + (size_t)(row - NLAT) * DM) + lane;
        f32x4 v[8]; float s = 0.f;
#pragma unroll
        for (int j = 0; j < 8; ++j) v[j] = __builtin_nontemporal_load(xr + 64 * j);
        if (part != nullptr && row >= NLAT) {
            for (int kb = 0; kb < nsplit; kb += 4) {
                f32x4 t[4][8];
#pragma unroll
                for (int q = 0; q < 4; ++q) { const GAS f32x4* pr = (const GAS f32x4*)(part + ((size_t)(kb + q) * NCTX + (row - NLAT)) * DM) + lane;
#pragma unroll
                    for (int j = 0; j < 8; ++j) t[q][j] = __builtin_nontemporal_load(pr + 64 * j); }
#pragma unroll
                for (int j = 0; j < 8; ++j) v[j] += (t[0][j] + t[1][j]) + (t[2][j] + t[3][j]); }
            GAS f32x4* xo = (GAS f32x4*)(xs_out + (size_t)row * DM) + lane;
#pragma unroll
            for (int j = 0; j < 8; ++j) xo[64 * j] = v[j];
        }
#pragma unroll
        for (int j = 0; j < 8; ++j) s += (v[j].x * v[j].x + v[j].y * v[j].y) + (v[j].z * v[j].z + v[j].w * v[j].w);
        const float rstd = 1.f / sqrtf(wave_sum(s, lane) * (1.f / DM) + EPS);
        GAS u32x2* o8 = (GAS u32x2*)(H + (size_t)row * DM) + lane;
#pragma unroll
        for (int j = 0; j < 8; ++j) { const int col = 4 * lane + 256 * j;
            const f32x4 g = *(const GAS f32x4*)(gn + col), sc = *(const GAS f32x4*)(mb + sc_off + col), sh = *(const GAS f32x4*)(mb + sh_off + col);
            const f32x4 y = v[j] * rstd * g * (sc + 1.f) + sh;
            u32x2 w; w.x = pk2(y.x, y.y); w.y = pk2(y.z, y.w); o8[64 * j] = w; }
    }
}

DI void phase_qknorm(const Ctx& C, bf16_t* Z, const float* qkg  , const float* ropec, const float* ropes) {
    const int lane = C.lane; const int gidx = (C.bid * NTHREADS + C.tid) >> 3, NG = (C.G * NTHREADS) >> 3, t8 = lane & 7;
    constexpr int NIT = MROWS * 42;
    for (int it0 = gidx; it0 < NIT; it0 += 4 * NG) {
        u32x4 raw[4]; bf16_t* pp[4];
#pragma unroll
        for (int j = 0; j < 4; ++j) { const int it = min(it0 + j * NG, NIT - 1); const int row = it / 42, s = it % 42;
            const int col = s < 8 ? Z_AQ + 64 * s : s < 10 ? Z_AK + 64 * (s - 8) : s < 18 ? Z_BQ + 64 * (s - 10) : s < 26 ? Z_BK + 64 * (s - 18) : s < 34 ? Z_DQ + 64 * (s - 26) : Z_DK + 64 * (s - 34);
            pp[j] = Z + (size_t)row * ZW + col + 8 * t8; raw[j] = *(const GAS u32x4*)pp[j]; }
#pragma unroll
        for (int j = 0; j < 4; ++j) {
            const int it = it0 + j * NG; const int itc = min(it, NIT - 1); const int row = itc / 42, s = itc % 42;
            const int gi = s < 8 ? 0 : s < 10 ? 1 : s < 18 ? 2 : s < 26 ? 3 : s < 34 ? 4 : 5;
            const bool rope = (gi != 2 && gi != 3), isq = !(gi & 1);
            const u32x4 rw = raw[j];
            float x[8] = {bflo(rw.x), bfhi(rw.x), bflo(rw.y), bfhi(rw.y), bflo(rw.z), bfhi(rw.z), bflo(rw.w), bfhi(rw.w)};
            float ss = 0.f;
#pragma unroll
            for (int i = 0; i < 8; ++i) ss += x[i] * x[i];
            ss += shx(ss, 1, lane); ss += shx(ss, 2, lane); ss += shx(ss, 4, lane);
            const float rstd = 1.f / sqrtf(ss * (1.f / 64.f) + EPS);
            const f32x4 g0 = *(const GAS f32x4*)(qkg + gi * 64 + 8 * t8), g1 = *(const GAS f32x4*)(qkg + gi * 64 + 8 * t8 + 4);
            x[0] *= rstd * g0.x; x[1] *= rstd * g0.y; x[2] *= rstd * g0.z; x[3] *= rstd * g0.w; x[4] *= rstd * g1.x; x[5] *= rstd * g1.y; x[6] *= rstd * g1.z; x[7] *= rstd * g1.w;
            float px[8];
#pragma unroll
            for (int i = 0; i < 8; ++i) px[i] = shx(x[i], 2, lane);
            if (rope && row < NLAT) {
                const int tok = row & (SEQ - 1), ab = tok * 32 + (t8 & 1) * 8 + (t8 >> 2) * 16;
                const f32x4 c0 = *(const GAS f32x4*)(ropec + ab), c1 = *(const GAS f32x4*)(ropec + ab + 4), s0 = *(const GAS f32x4*)(ropes + ab), s1 = *(const GAS f32x4*)(ropes + ab + 4);
                const float cc[8] = {c0.x, c0.y, c0.z, c0.w, c1.x, c1.y, c1.z, c1.w}, sn[8] = {s0.x, s0.y, s0.z, s0.w, s1.x, s1.y, s1.z, s1.w};
                const float sg = (t8 & 2) ? 1.f : -1.f;
#pragma unroll
                for (int i = 0; i < 8; ++i) x[i] = x[i] * cc[i] + sg * px[i] * sn[i];
            }
            if (isq) {
#pragma unroll
                for (int i = 0; i < 8; ++i) x[i] *= QSCALE;
            }
            u32x4 w; w.x = pk2(x[0], x[1]); w.y = pk2(x[2], x[3]); w.z = pk2(x[4], x[5]); w.w = pk2(x[6], x[7]);
            if (it < NIT) *(GAS u32x4*)pp[j] = w;
        }
    }
}

template <int MODE> struct AttnCfg {
    static constexpr int NS = MODE == 1 ? 1 : 2, DV = MODE == 2 ? 128 : 64, KW = MODE == 2 ? 128 : 64, KST = KW + 8, NDVB = DV / 16, NVC = DV / 64, NKC = KW / 64;
};
constexpr int AT_BUF = 36864, AT_KS = 0, AT_VT = 17408, AT_BT = 2 * AT_BUF, VST = 72;

template <int MODE, int NKB>
DI void attn_tile(const LAS bf16_t* Ks, const LAS bf16_t* Vt, const bf16x8 (&qf)[AttnCfg<MODE>::NS][2], const float negm, float (&lsum)[AttnCfg<MODE>::NS],
                  f32x4 (&o)[AttnCfg<MODE>::NS][AttnCfg<MODE>::NDVB], int kb0  , int l15, int quad, int lane, bool masked, int mp, const LAS float* brow) {
    using Cf = AttnCfg<MODE>; constexpr int NS = Cf::NS, KST = Cf::KST, NDVB = Cf::NDVB;
    f32x4 st[NS][NKB];
#pragma unroll
    for (int i = 0; i < NKB; ++i) { const LAS bf16_t* kp = Ks + (kb0 + 16 * i + l15) * KST + 8 * quad;
#pragma unroll
        for (int s = 0; s < NS; ++s) st[s][i] = (f32x4){negm, negm, negm, negm};
#pragma unroll
        for (int kc = 0; kc < 2; ++kc) {
            if (MODE == 2) {
#pragma unroll
                for (int s = 0; s < NS; ++s) { const bf16x8 a = *(const LAS bf16x8*)(kp + 64 * s + 32 * kc); st[s][i] = __builtin_amdgcn_mfma_f32_16x16x32_bf16(a, qf[s][kc], st[s][i], 0, 0, 0); }
                if (kc == 1 && (i & 1)) __builtin_amdgcn_sched_barrier(0);
            } else { const bf16x8 a = *(const LAS bf16x8*)(kp + 32 * kc);
#pragma unroll
                for (int s = 0; s < NS; ++s) st[s][i] = __builtin_amdgcn_mfma_f32_16x16x32_bf16(a, qf[s][kc], st[s][i], 0, 0, 0); } } }
    if (MODE == 2) __builtin_amdgcn_sched_barrier(0);
    if (masked) {
        if (MODE == 0) {
#pragma unroll
            for (int i = 0; i < NKB; ++i)
#pragma unroll
                for (int r = 0; r < 4; ++r) { const int d = mp - (kb0 + 16 * i + 4 * quad + r); const bool bad = (d > 128) || (d < -128);
#pragma unroll
                    for (int s = 0; s < NS; ++s) st[s][i][r] = bad ? NEGBIG : st[s][i][r]; }
        }
        if (MODE == 1) {
#pragma unroll
            for (int i = 0; i < NKB; ++i)
#pragma unroll
                for (int r = 0; r < 4; ++r) { const int key = kb0 + 16 * i + 4 * quad + r; const bool valid = (key >= mp) && (key < mp + 16);
                    const float bias = valid ? brow[key] : 0.f; st[0][i][r] = valid ? st[0][i][r] + bias : NEGBIG; }
        }
    }
    bf16x8 pf[NS][NKB / 2];
#pragma unroll
    for (int s = 0; s < NS; ++s) {
        if (MODE == 2) __builtin_amdgcn_sched_barrier(0);
        float ps = 0.f;
#pragma unroll
        for (int i = 0; i < NKB; ++i)
#pragma unroll
            for (int r = 0; r < 4; ++r) { const float p = fast_exp2(st[s][i][r]); st[s][i][r] = p; ps += p; }
        lsum[s] += ps;
#pragma unroll
        for (int c = 0; c < NKB / 2; ++c) { u32x4 pw; pw.x = pk2(st[s][2 * c][0], st[s][2 * c][1]); pw.y = pk2(st[s][2 * c][2], st[s][2 * c][3]); pw.z = pk2(st[s][2 * c + 1][0], st[s][2 * c + 1][1]); pw.w = pk2(st[s][2 * c + 1][2], st[s][2 * c + 1][3]);
            pf[s][c] = __builtin_bit_cast(bf16x8, pw); }
    }
    if (MODE == 2) __builtin_amdgcn_sched_barrier(0);
#pragma unroll
    for (int d = 0; d < NDVB; ++d)
#pragma unroll
        for (int c = 0; c < NKB / 2; ++c) { const LAS bf16_t* vp = Vt + (16 * d + l15) * VST + kb0 + 32 * c + 4 * quad;
            const u32x2 lo = *(const LAS u32x2*)vp, hi = *(const LAS u32x2*)(vp + 16);
            u32x4 av; av.x = lo.x; av.y = lo.y; av.z = hi.x; av.w = hi.y; const bf16x8 avv = __builtin_bit_cast(bf16x8, av);
#pragma unroll
            for (int s = 0; s < NS; ++s) o[s][d] = __builtin_amdgcn_mfma_f32_16x16x32_bf16(avv, pf[s][c], o[s][d], 0, 0, 0);
            if (MODE == 2 && c == NKB / 2 - 1 && (d & 1)) __builtin_amdgcn_sched_barrier(0); }
}

template <int MODE>
DI void attn_unit(const Ctx& C, const bf16_t* __restrict__ Z, bf16_t* __restrict__ Y, int b, int qsel, int hsel, bool ctxq,
                  const float* sinkp, const float* rpb_h, float lam, float post_scale, const float* subln, const float mref) {
    using Cf = AttnCfg<MODE>; constexpr int NS = Cf::NS, KST = Cf::KST, NDVB = Cf::NDVB, NVC = Cf::NVC, NKC = Cf::NKC;
    const int tid = C.tid, lane = C.lane, w = C.wave, l15 = lane & 15, quad = lane >> 4;
    constexpr int QB = MODE == 0 ? 64 : 128;
    const int qi = MODE == 0 ? 16 * (w & 3) + l15 : 16 * w + l15;
    const int qrow = (ctxq ? NLAT + 256 * b : b * SEQ) + QB * qsel + qi;
    int qcol[NS], kcol, vcol, ycol[NS];
    if (MODE == 0) { const int h0 = 4 * hsel + 2 * (w >> 2); qcol[0] = Z_AQ + 64 * h0; qcol[NS - 1] = Z_AQ + 64 * (h0 + 1); kcol = Z_AK + 64 * hsel; vcol = Z_AV + 64 * hsel; ycol[0] = 64 * h0; ycol[NS - 1] = 64 * (h0 + 1); }
    else if (MODE == 1) { qcol[0] = Z_BQ + 64 * hsel; kcol = Z_BK + 64 * hsel; vcol = Z_BV + 64 * hsel; ycol[0] = 512 + 64 * hsel; }
    else { qcol[0] = Z_DQ + 128 * hsel; qcol[NS - 1] = qcol[0] + 64; kcol = Z_DK + 128 * hsel; vcol = Z_DV + 128 * hsel; ycol[0] = 1536 + 128 * hsel; ycol[NS - 1] = ycol[0]; }
    int lt0 = 0, nlat = 0;
    if (!ctxq) {
        if (MODE == 0) { lt0 = max(0, qsel - 2); nlat = min(31, qsel + 2) - lt0 + 1; }
        else if (MODE == 1) { const int rs0 = min(max(2 * qsel - 4, 0), 24), rs1 = min(max(2 * qsel - 3, 0), 24); lt0 = rs0; nlat = rs1 + 8 - rs0; }
        else { lt0 = 0; nlat = 32; }
    }
    const int nt = 4 + nlat;
    LAS bf16_t* lds16 = (LAS bf16_t*)C.lds;
    LAS float* bt = (LAS float*)(C.lds + AT_BT);
    const int qpos = 64 * qsel + qi;
    const int grow_q = 2 * qsel + (w >> 2), qcp = 16 * (w & 3) + l15;
    const int cs_q = min(max(qcp - 8, 0), 48), rs_r = min(max(grow_q - 4, 0), 24);
    const int kb0_lat = min(max(16 * (w & 3) - 8, 0), 32);
    bf16x8 qf[NS][2];
#pragma unroll
    for (int s = 0; s < NS; ++s) { const bf16_t* qp = Z + (size_t)qrow * ZW + qcol[s] + 8 * quad; qf[s][0] = *(const GAS bf16x8*)(qp); qf[s][1] = *(const GAS bf16x8*)(qp + 32); }
    const float negm = -mref;
    float lsum[NS]; f32x4 o[NS][NDVB];
#pragma unroll
    for (int s = 0; s < NS; ++s) { lsum[s] = 0.f;
#pragma unroll
        for (int d = 0; d < NDVB; ++d) o[s][d] = (f32x4){0.f, 0.f, 0.f, 0.f}; }
    if (MODE == 0) {
#pragma unroll
        for (int s = 0; s < NS; ++s) lsum[s] = quad == 0 ? fast_exp2(sinkp[4 * hsel + 2 * (w >> 2) + s] * LOG2E - mref) : 0.f; }
    u32x4 kA[NKC], vA[NVC], kB[NKC], vB[NVC];
    const int krow = tid >> 3, kch = tid & 7;
#define TILE_ROW(t) ((t) < 4 ? (NLAT + 256 * b + 64 * (t)) : (b * SEQ + 64 * (lt0 + (t) - 4)))
    const int vp2 = 2 * (lane & 31), vhs = lane >> 5;
    const unsigned koff = (unsigned)(krow * ZW + kcol + 8 * kch), voff = NVC == 2 ? (unsigned)(vp2 * ZW + vcol + 8 * (2 * w + vhs)) : (unsigned)(lane * ZW + vcol + 8 * w);
#define ISSUE(t, KR, VR) do { const GAS bf16_t* tb_ = (const GAS bf16_t*)Z + (size_t)TILE_ROW(t) * ZW; \
        _Pragma("unroll") for (int j_ = 0; j_ < NKC; ++j_) KR[j_] = *(const GAS u32x4*)(tb_ + koff + 64 * j_); \
        if (NVC == 2) { VR[0] = *(const GAS u32x4*)(tb_ + voff); VR[NVC - 1] = *(const GAS u32x4*)(tb_ + voff + ZW); } \
        else { VR[0] = *(const GAS u32x4*)(tb_ + voff); } } while (0)
#define VPK_LO(a, b) (((a) & 0xffffu) | ((b) << 16))
#define VPK_HI(a, b) (((a) >> 16) | ((b) & 0xffff0000u))
#define WRITE(bi, KR, VR) do { LAS bf16_t* ks_ = lds16 + ((bi) * AT_BUF + AT_KS) / 2; LAS bf16_t* vt_ = lds16 + ((bi) * AT_BUF + AT_VT) / 2; \
        _Pragma("unroll") for (int j_ = 0; j_ < NKC; ++j_) *(LAS u32x4*)(ks_ + krow * KST + 64 * j_ + 8 * kch) = KR[j_]; \
        if (NVC == 2) { LAS unsigned* p_ = (LAS unsigned*)(vt_ + (8 * (2 * w + vhs)) * VST + vp2); const u32x4 a_ = VR[0], b_ = VR[NVC - 1]; \
            p_[0] = VPK_LO(a_.x, b_.x); p_[VST / 2] = VPK_HI(a_.x, b_.x); p_[2 * (VST / 2)] = VPK_LO(a_.y, b_.y); p_[3 * (VST / 2)] = VPK_HI(a_.y, b_.y); \
            p_[4 * (VST / 2)] = VPK_LO(a_.z, b_.z); p_[5 * (VST / 2)] = VPK_HI(a_.z, b_.z); p_[6 * (VST / 2)] = VPK_LO(a_.w, b_.w); p_[7 * (VST / 2)] = VPK_HI(a_.w, b_.w); } \
        else { LAS bf16_t* p_ = vt_ + (8 * w) * VST + lane; const u32x4 r_ = VR[0]; \
            p_[0] = (bf16_t)(r_.x & 0xffffu); p_[VST] = (bf16_t)(r_.x >> 16); p_[2 * VST] = (bf16_t)(r_.y & 0xffffu); p_[3 * VST] = (bf16_t)(r_.y >> 16); \
            p_[4 * VST] = (bf16_t)(r_.z & 0xffffu); p_[5 * VST] = (bf16_t)(r_.z >> 16); p_[6 * VST] = (bf16_t)(r_.w & 0xffffu); p_[7 * VST] = (bf16_t)(r_.w >> 16); } } while (0)
    ISSUE(0, kA, vA); ISSUE(1, kB, vB);
    __syncthreads();
    if (MODE == 1 && !ctxq) { for (int i = tid; i < 15 * 31; i += NTHREADS) bt[i] = rpb_h[i] * LOG2E; }
    WRITE(0, kA, vA); ISSUE(2, kA, vA);
    __syncthreads();
    for (int t = 0; t < nt; ++t) {
        if (t + 1 < nt) {
            if ((t + 1) & 1) { WRITE(1, kB, vB); if (t + 3 < nt) ISSUE(t + 3, kB, vB); }
            else { WRITE(0, kA, vA); if (t + 3 < nt) ISSUE(t + 3, kA, vA); }
        }
        const LAS bf16_t* Ks = lds16 + ((t & 1) * AT_BUF + AT_KS) / 2; const LAS bf16_t* Vt = lds16 + ((t & 1) * AT_BUF + AT_VT) / 2;
        const int ltile = lt0 + t - 4;
        if (MODE == 2) attn_tile<MODE, 4>(Ks, Vt, qf, negm, lsum, o, 0, l15, quad, lane, false, 0, bt);
        else if (MODE == 0) { const int qlo = 64 * qsel + 16 * (w & 3); const bool active = (t < 4) || ((64 * ltile + 63 >= qlo - 128) && (64 * ltile <= qlo + 15 + 128));
            if (active) attn_tile<MODE, 4>(Ks, Vt, qf, negm, lsum, o, 0, l15, quad, lane, t >= 4, qpos - 64 * ltile, bt); }
        else { if (t < 4) attn_tile<MODE, 4>(Ks, Vt, qf, negm, lsum, o, 0, l15, quad, lane, false, 0, bt);
            else { const bool active = (ltile >= rs_r) && (ltile < rs_r + 8);
                if (active) attn_tile<MODE, 2>(Ks, Vt, qf, negm, lsum, o, kb0_lat, l15, quad, lane, true, cs_q, bt + (ltile - grow_q + 7) * 31 + 15 - qcp); } }
        __syncthreads();
    }
#undef ISSUE
#undef WRITE
#undef VPK_LO
#undef VPK_HI
#undef TILE_ROW
    float linv[NS];
#pragma unroll
    for (int s = 0; s < NS; ++s) { float l = lsum[s]; l += shx(l, 16, lane); l += shx(l, 32, lane); linv[s] = 1.f / l; }
    if (MODE != 2) {
#pragma unroll
        for (int s = 0; s < NS; ++s) { bf16_t* yp = Y + (size_t)qrow * DM + ycol[s] + 4 * quad;
#pragma unroll
            for (int d = 0; d < NDVB; ++d) { const f32x4 v = o[s][d] * linv[s]; u32x2 wv; wv.x = pk2(v[0], v[1]); wv.y = pk2(v[2], v[3]); *(GAS u32x2*)(yp + 16 * d) = wv; } }
    } else {
        bf16_t* yp = Y + (size_t)qrow * DM + ycol[0] + 4 * quad;
        f32x4 r[NDVB]; float ss = 0.f; const float l2 = lam * linv[NS - 1];
#pragma unroll
        for (int d = 0; d < NDVB; ++d) { r[d] = o[0][d] * linv[0] - o[NS - 1][d] * l2; ss += (r[d][0] * r[d][0] + r[d][1] * r[d][1]) + (r[d][2] * r[d][2] + r[d][3] * r[d][3]); }
        ss += shx(ss, 16, lane); ss += shx(ss, 32, lane);
        const float rs = post_scale / sqrtf(ss * (1.f / 128.f) + EPS);
#pragma unroll
        for (int d = 0; d < NDVB; ++d) { const f32x4 g = *(const GAS f32x4*)(subln + 16 * d + 4 * quad); const f32x4 v = r[d] * rs * g;
            u32x2 wv; wv.x = pk2(v[0], v[1]); wv.y = pk2(v[2], v[3]); *(GAS u32x2*)(yp + 16 * d) = wv; }
    }
}

typedef float f32x16 __attribute__((ext_vector_type(16)));
DI void attn_unit_d32(const Ctx& C, const bf16_t* __restrict__ Z, bf16_t* __restrict__ Y, int b, int qsel, int hsel, bool ctxq, float lam, float post_scale, const float* subln, const float mref) {
    constexpr int KST = 136, VST = 72, AT_VT = 64 * 136 * 2;
    const int tid = C.tid, lane = C.lane, w = C.wave, l31 = lane & 31, hh = lane >> 5, sm = w >> 2, qg = w & 3;
    const int qrow = (ctxq ? NLAT + 256 * b : b * SEQ) + 128 * qsel + 32 * qg + l31;
    const int qcol = Z_DQ + 128 * hsel + 64 * sm, kcol = Z_DK + 128 * hsel, vcol = Z_DV + 128 * hsel, ycol = 1536 + 128 * hsel;
    const int nt = ctxq ? 4 : 36;
    LAS bf16_t* lds16 = (LAS bf16_t*)C.lds;
    bf16x8 qf[4];
#pragma unroll
    for (int ks = 0; ks < 4; ++ks) qf[ks] = *(const GAS bf16x8*)(Z + (size_t)qrow * ZW + qcol + 16 * ks + 8 * hh);
    const float negm = -mref;
    f32x16 o[4]; float lsum = 0.f;
#pragma unroll
    for (int d = 0; d < 4; ++d)
#pragma unroll
        for (int r = 0; r < 16; ++r) o[d][r] = 0.f;
    u32x4 kA[2], vA[2], kB[2], vB[2];
    const int krow = tid >> 3, kch = tid & 7, vp2 = 2 * (lane & 31), vhs = lane >> 5;
#define TILE_ROW(t) ((t) < 4 ? (NLAT + 256 * b + 64 * (t)) : (b * SEQ + 64 * ((t) - 4)))
    const unsigned koff = (unsigned)(krow * ZW + kcol + 8 * kch), voff = (unsigned)(vp2 * ZW + vcol + 8 * (2 * w + vhs));
#define ISSUE(t, KR, VR) do { const GAS bf16_t* tb_ = (const GAS bf16_t*)Z + (size_t)TILE_ROW(t) * ZW; \
        KR[0] = *(const GAS u32x4*)(tb_ + koff); KR[1] = *(const GAS u32x4*)(tb_ + koff + 64); \
        VR[0] = *(const GAS u32x4*)(tb_ + voff); VR[1] = *(const GAS u32x4*)(tb_ + voff + ZW); } while (0)
#define VPK_LO(a, b) (((a) & 0xffffu) | ((b) << 16))
#define VPK_HI(a, b) (((a) >> 16) | ((b) & 0xffff0000u))
#define WRITE(bi, KR, VR) do { LAS bf16_t* ks_ = lds16 + ((bi) * AT_BUF) / 2; LAS bf16_t* vt_ = lds16 + ((bi) * AT_BUF + AT_VT) / 2; \
        *(LAS u32x4*)(ks_ + krow * KST + 8 * kch) = KR[0]; *(LAS u32x4*)(ks_ + krow * KST + 64 + 8 * kch) = KR[1]; \
        LAS unsigned* p_ = (LAS unsigned*)(vt_ + (8 * (2 * w + vhs)) * VST + vp2); const u32x4 a_ = VR[0], b_ = VR[1]; \
        p_[0] = VPK_LO(a_.x, b_.x); p_[VST / 2] = VPK_HI(a_.x, b_.x); p_[2 * (VST / 2)] = VPK_LO(a_.y, b_.y); p_[3 * (VST / 2)] = VPK_HI(a_.y, b_.y); \
        p_[4 * (VST / 2)] = VPK_LO(a_.z, b_.z); p_[5 * (VST / 2)] = VPK_HI(a_.z, b_.z); p_[6 * (VST / 2)] = VPK_LO(a_.w, b_.w); p_[7 * (VST / 2)] = VPK_HI(a_.w, b_.w); } while (0)
    ISSUE(0, kA, vA); ISSUE(1, kB, vB);
    __syncthreads();
    WRITE(0, kA, vA); ISSUE(2, kA, vA);
    __syncthreads();
    for (int t = 0; t < nt; ++t) {
        if (t + 1 < nt) {
            if ((t + 1) & 1) { WRITE(1, kB, vB); if (t + 3 < nt) ISSUE(t + 3, kB, vB); }
            else { WRITE(0, kA, vA); if (t + 3 < nt) ISSUE(t + 3, kA, vA); }
        }
        const LAS bf16_t* Ks = lds16 + ((t & 1) * AT_BUF) / 2 + 64 * sm; const LAS bf16_t* Vt = lds16 + ((t & 1) * AT_BUF + AT_VT) / 2;
        f32x16 st[2];
#pragma unroll
        for (int kb = 0; kb < 2; ++kb) {
#pragma unroll
            for (int r = 0; r < 16; ++r) st[kb][r] = negm;
#pragma unroll
            for (int ks = 0; ks < 4; ++ks) { const bf16x8 a = *(const LAS bf16x8*)(Ks + (32 * kb + l31) * KST + 16 * ks + 8 * hh);
                st[kb] = __builtin_amdgcn_mfma_f32_32x32x16_bf16(a, qf[ks], st[kb], 0, 0, 0); } }
        bf16x8 pf[2][2]; float ps = 0.f;
#pragma unroll
        for (int kb = 0; kb < 2; ++kb) {
#pragma unroll
            for (int r = 0; r < 16; ++r) { const float p = fast_exp2(st[kb][r]); st[kb][r] = p; ps += p; }
#pragma unroll
            for (int s = 0; s < 2; ++s) { u32x4 pw; pw.x = pk2(st[kb][8 * s], st[kb][8 * s + 1]); pw.y = pk2(st[kb][8 * s + 2], st[kb][8 * s + 3]); pw.z = pk2(st[kb][8 * s + 4], st[kb][8 * s + 5]); pw.w = pk2(st[kb][8 * s + 6], st[kb][8 * s + 7]);
                pf[kb][s] = __builtin_bit_cast(bf16x8, pw); } }
        lsum += ps;
#pragma unroll
        for (int d = 0; d < 4; ++d)
#pragma unroll
            for (int kb = 0; kb < 2; ++kb)
#pragma unroll
                for (int s = 0; s < 2; ++s) { const LAS bf16_t* vp = Vt + (32 * d + l31) * VST + 32 * kb + 16 * s + 4 * hh;
                    const u32x2 lo = *(const LAS u32x2*)vp, hi = *(const LAS u32x2*)(vp + 8);
                    u32x4 av; av.x = lo.x; av.y = lo.y; av.z = hi.x; av.w = hi.y;
                    o[d] = __builtin_amdgcn_mfma_f32_32x32x16_bf16(__builtin_bit_cast(bf16x8, av), pf[kb][s], o[d], 0, 0, 0); }
        __syncthreads();
    }
#undef ISSUE
#undef WRITE
#undef VPK_LO
#undef VPK_HI
#undef TILE_ROW
    float l = lsum; l += shx(l, 32, lane); const float linv = 1.f / l;
    LAS float* X = (LAS float*)C.lds + (32 * qg + l31) * 132;
    if (sm == 1) {
#pragma unroll
        for (int d = 0; d < 4; ++d)
#pragma unroll
            for (int g = 0; g < 4; ++g) { const f32x4 v = {o[d][4 * g] * linv, o[d][4 * g + 1] * linv, o[d][4 * g + 2] * linv, o[d][4 * g + 3] * linv};
                *(LAS f32x4*)(X + 32 * d + 8 * g + 4 * hh) = v; }
    }
    __syncthreads();
    if (sm == 0) {
        f32x4 r[4][4]; float ss = 0.f;
#pragma unroll
        for (int d = 0; d < 4; ++d)
#pragma unroll
            for (int g = 0; g < 4; ++g) { const f32x4 x2 = *(const LAS f32x4*)(X + 32 * d + 8 * g + 4 * hh);
                const f32x4 x1 = {o[d][4 * g] * linv, o[d][4 * g + 1] * linv, o[d][4 * g + 2] * linv, o[d][4 * g + 3] * linv};
                r[d][g] = x1 - x2 * lam; ss += (r[d][g][0] * r[d][g][0] + r[d][g][1] * r[d][g][1]) + (r[d][g][2] * r[d][g][2] + r[d][g][3] * r[d][g][3]); }
        ss += shx(ss, 32, lane);
        const float rs = post_scale / sqrtf(ss * (1.f / 128.f) + EPS);
        bf16_t* yp = Y + (size_t)qrow * DM + ycol;
#pragma unroll
        for (int d = 0; d < 4; ++d)
#pragma unroll
            for (int g = 0; g < 4; ++g) { const int dv = 32 * d + 8 * g + 4 * hh; const f32x4 gn = *(const GAS f32x4*)(subln + dv); const f32x4 v = r[d][g] * rs * gn;
                u32x2 wv; wv.x = pk2(v[0], v[1]); wv.y = pk2(v[2], v[3]); *(GAS u32x2*)(yp + dv) = wv; }
    }
    __syncthreads();
}

DI void pool_unit(const Ctx& C, const bf16_t* __restrict__ Z, bf16_t* __restrict__ Y, const bf16_t* cwT  , const float* cscale, int tile, int g) {
    const int tid = C.tid, lane = C.lane, w = C.wave, l15 = lane & 15, quad = lane >> 4;
    const int R0 = tile * 64;
    int S0, S1; if (R0 < NLAT) { S0 = R0 & ~(SEQ - 1); S1 = S0 + SEQ; } else { S0 = NLAT + ((R0 - NLAT) & ~(CTXL - 1)); S1 = S0 + CTXL; }
    LAS float* U = (LAS float*)C.lds;
    LAS bf16_t* P = (LAS bf16_t*)(C.lds + 80 * 132 * 4);
    __syncthreads();
    { u32x4 vv[3];
#pragma unroll
      for (int k = 0; k < 3; ++k) { const int i = tid + k * NTHREADS, rr = i >> 4, ch = i & 15, grow = R0 - 8 + rr;
          vv[k] = (u32x4){0u, 0u, 0u, 0u};
          if (i < 80 * 16 && grow >= S0 && grow < S1) vv[k] = *(const GAS u32x4*)(Z + (size_t)grow * ZW + Z_CU + 128 * g + 8 * ch); }
#pragma unroll
      for (int k = 0; k < 3; ++k) { const int i = tid + k * NTHREADS, rr = i >> 4, ch = i & 15; const u32x4 v = vv[k];
          if (i < 80 * 16) { LAS float* up = U + rr * 132 + 8 * ch;
              up[0] = bflo(v.x); up[1] = bfhi(v.x); up[2] = bflo(v.y); up[3] = bfhi(v.y); up[4] = bflo(v.z); up[5] = bfhi(v.z); up[6] = bflo(v.w); up[7] = bfhi(v.w); } } }
    __syncthreads();
    { const int wsz = 2 << g, hw = wsz >> 1, ch = tid & 127, tg = tid >> 7;
      const LAS float* up = U + ch; const int t0 = tg * 16;
      float s = 0.f; for (int rr = t0 + 8 - hw; rr < t0 + 8 - hw + wsz; ++rr) s += up[rr * 132];
      for (int tt = 0; tt < 16; ++tt) { const int t = t0 + tt, grow = R0 + t; const int lo = max(grow - hw, S0), hi = min(grow + wsz - 1 - hw, S1 - 1);
          const float pooled = s / (float)(hi - lo + 1) - up[(t + 8) * 132];
          P[t * 136 + ch] = (bf16_t)(pk2(pooled, 0.f) & 0xffffu);
          s += up[(t + 8 - hw + wsz) * 132] - up[(t + 8 - hw) * 132]; } }
    __syncthreads();
    f32x4 acc[4];
#pragma unroll
    for (int tb = 0; tb < 4; ++tb) acc[tb] = (f32x4){0.f, 0.f, 0.f, 0.f};
    const bf16_t* wp = cwT + ((size_t)g * 128 + 16 * w + l15) * 128 + 8 * quad;
#pragma unroll
    for (int kc = 0; kc < 4; ++kc) { const bf16x8 a = *(const GAS bf16x8*)(wp + 32 * kc);
#pragma unroll
        for (int tb = 0; tb < 4; ++tb) { const bf16x8 bb = *(const LAS bf16x8*)(P + (16 * tb + l15) * 136 + 32 * kc + 8 * quad);
            acc[tb] = __builtin_amdgcn_mfma_f32_16x16x32_bf16(a, bb, acc[tb], 0, 0, 0); } }
    const int e0 = 128 * g + 16 * w + 4 * quad; const f32x4 sc = *(const GAS f32x4*)(cscale + e0);
#pragma unroll
    for (int tb = 0; tb < 4; ++tb) { const f32x4 v = acc[tb] * sc; u32x2 wv; wv.x = pk2(v[0], v[1]); wv.y = pk2(v[2], v[3]);
        *(GAS u32x2*)(Y + (size_t)(R0 + 16 * tb + l15) * DM + 1024 + e0) = wv; }
}

#ifndef UDUP
#define UDUP 0
#endif
#ifndef UMASK
#define UMASK 15
#endif
#ifndef PMASK
#define PMASK 1023
#endif
DI void phase_mixers(const Ctx& C, int l, bool last) {
    unsigned char* ws = ARGWS(C);
    const bf16_t* Z = (const bf16_t*)(ws + WS_Z); bf16_t* Y = (bf16_t*)(ws + WS_Y);
    const float* misc = (const float*)(ws + WS_MISC);
    const float lam = misc[l], post = misc[2 + l], mA = misc[8 + 4 * l], mB = misc[9 + 4 * l], mD = misc[10 + 4 * l];
    const float* sink = ARGP(C, 11) + l * 8; const float* rpb = ARGP(C, 12) + (size_t)l * 8 * 15 * 31; const float* subln = ARGP(C, 16) + l * 128;
    const bf16_t* cwT = (const bf16_t*)(ws + WS_CWT) + (size_t)l * 4 * 128 * 128; const float* cscale = ARGP(C, 14) + l * 512;
    const int nC = last ? (NLAT / 64) * 4 : (MROWS / 64) * 4;
    for (int rep = 0; rep < ((UDUP & 1) ? 2 : 1); ++rep)
    if (UMASK & 1) for (int u = C.bid; u < 256; u += C.G) { const int b = u >> 6, qb = (u >> 2) & 15, h = u & 3; attn_unit_d32(C, Z, Y, b, qb, h, false, lam, post, subln, mD); }
    for (int rep = 0; rep < ((UDUP & 2) ? 2 : 1); ++rep)
    if (UMASK & 2) for (int u = C.bid; u < 256; u += C.G) { const int b = u >> 6, qb = (u >> 1) & 31, g = u & 1; attn_unit<0>(C, Z, Y, b, qb, g, false, sink, nullptr, 0.f, 0.f, nullptr, mA); }
    for (int rep = 0; rep < ((UDUP & 4) ? 2 : 1); ++rep)
    if (UMASK & 4) for (int u = C.bid; u < 512; u += C.G) { const int b = u >> 7, rp = (u >> 3) & 15, h = u & 7; attn_unit<1>(C, Z, Y, b, rp, h, false, nullptr, rpb + h * 15 * 31, 0.f, 0.f, nullptr, mB); }
    for (int rep = 0; rep < ((UDUP & 8) ? 2 : 1); ++rep)
    if (UMASK & 8) for (int u = C.bid; u < nC; u += C.G) pool_unit(C, Z, Y, cwT, cscale, u >> 2, u & 3);
    if (!last) {
        const int rb = C.G - 1 - C.bid;
        if (UMASK & 2) for (int u = rb; u < 32; u += C.G) { const int b = u >> 3, qb = (u >> 1) & 3, g = u & 1; attn_unit<0>(C, Z, Y, b, qb, g, true, sink, nullptr, 0.f, 0.f, nullptr, mA); }
        if (UMASK & 4) for (int u = rb - 32; u < 64; u += C.G) { if (u >= 0) { const int b = u >> 4, hq = (u >> 3) & 1, h = u & 7; attn_unit<1>(C, Z, Y, b, hq, h, true, nullptr, nullptr, 0.f, 0.f, nullptr, mB); } }
        if (UMASK & 1) for (int u = rb - 96; u < 32; u += C.G) { if (u >= 0) { const int b = u >> 3, hq = (u >> 2) & 1, h = u & 3; attn_unit_d32(C, Z, Y, b, hq, h, true, lam, post, subln, mD); } }
    }
}

constexpr int N_PHASES = 19;

#define XB_TMO      128
#define XB_XCNT(j)  (256  + 64 * (j))
#define XB_XSUB(j)  (1280 + 64 * (j))
#define XB_XGEN(j)  (2304 + 64 * (j))
#define XB_TOP      3328
#define XB_TOPGEN   3392
#define XCD_BAR_WORDS 3456
#define XB_SPIN_CAP (1u << 18)
DI unsigned xb_ld(unsigned* p)              { return __hip_atomic_load(p, __ATOMIC_RELAXED, __HIP_MEMORY_SCOPE_AGENT); }
DI unsigned xb_add(unsigned* p, unsigned v) { return __hip_atomic_fetch_add(p, v, __ATOMIC_RELAXED, __HIP_MEMORY_SCOPE_AGENT); }
DI unsigned xb_xcc_id() { return (unsigned)__builtin_amdgcn_s_getreg((3 << 11) | 20) & 0xFu; }
#define XB_SPIN(cond, bar) do { unsigned _sp = 0; while (cond) { __builtin_amdgcn_s_sleep(1); \
    if ((++_sp & 255u) == 0u) { if (xb_ld(&(bar)[XB_TMO])) break; if (_sp > XB_SPIN_CAP) { atomicAdd(&(bar)[XB_TMO], 1u); break; } } } } while (0)
DI void xcd_barrier_complete(unsigned* bar, unsigned x, unsigned G, unsigned& nloc, unsigned& nx) {
    unsigned sum, cnt, mine, sp = 0u;
    for (;;) {
        sum = 0u; cnt = 0u; mine = 0u;
#pragma unroll
        for (unsigned j = 0; j < 16; ++j) { const unsigned c = xb_ld(&bar[XB_XCNT(j)]); sum += c; cnt += (c > 0u) ? 1u : 0u; mine = (j == x) ? c : mine; }
        if (sum == G) break;
        __builtin_amdgcn_s_sleep(1);
        if ((++sp & 255u) == 0u) { if (xb_ld(&bar[XB_TMO])) break; if (sp > XB_SPIN_CAP) { atomicAdd(&bar[XB_TMO], 1u); break; } }
    }
    nloc = mine > 0u ? mine : 1u; nx = cnt > 0u ? cnt : 1u;
}
DI void grid_barrier(const Ctx& C, unsigned* bar, volatile LAS unsigned* st) {
    asm volatile("s_waitcnt vmcnt(0)" ::: "memory");
    __syncthreads();
    if (C.tid == 0) {
        const unsigned x = xb_xcc_id();
        __builtin_amdgcn_s_waitcnt(0);
        unsigned nloc = st[0], nx = st[1];
        if (nloc == 0u) { xcd_barrier_complete(bar, x, (unsigned)C.G, nloc, nx); st[0] = nloc; st[1] = nx; }
        const unsigned old = xb_add(&bar[XB_XSUB(x)], 1u);
        const unsigned gen = old / nloc;
        if (old + 1u == (gen + 1u) * nloc) {
            __builtin_amdgcn_fence(__ATOMIC_RELEASE, "agent");
            asm volatile("s_waitcnt vmcnt(0)" ::: "memory");
            const unsigned og = xb_add(&bar[XB_TOP], 1u);
            const unsigned tg = og / nx;
            if (og + 1u == (tg + 1u) * nx) xb_add(&bar[XB_TOPGEN], 1u);
            else XB_SPIN(xb_ld(&bar[XB_TOPGEN]) == tg, bar);
            __builtin_amdgcn_fence(__ATOMIC_ACQUIRE, "agent");
            xb_add(&bar[XB_XGEN(x)], 1u);
            asm volatile("s_waitcnt vmcnt(0)" ::: "memory");
        } else {
            XB_SPIN(xb_ld(&bar[XB_XGEN(x)]) == gen, bar);
            __builtin_amdgcn_fence(__ATOMIC_ACQUIRE, "agent");
            asm volatile("s_waitcnt vmcnt(0)" ::: "memory");
        }
    }
    __syncthreads();
}

__global__ void __launch_bounds__(NTHREADS, 2) fwd_kernel(Args A) {
    extern __shared__ __attribute__((aligned(16))) unsigned char lds_raw[];
    if (A.ph_hi < 0) cg::this_grid().sync();
    const int wave_s = __builtin_amdgcn_readfirstlane((int)threadIdx.x >> 6);
    Ctx C; C.lds = (LAS unsigned char*)lds_raw; C.tid = threadIdx.x; C.lane = C.tid & 63; C.wave = wave_s; C.G = gridDim.x; C.bid = blockIdx.x;
#define REFRESH_CTX() do { int l_, w_ = wave_s, b_ = blockIdx.x, g_ = gridDim.x; \
        asm volatile("v_mbcnt_lo_u32_b32 %0, -1, 0\n\tv_mbcnt_hi_u32_b32 %0, -1, %0" : "=v"(l_)); asm volatile("" : "+s"(w_), "+s"(b_), "+s"(g_)); \
        C.tid = w_ * 64 + l_; C.lane = l_; C.wave = w_; C.G = g_; C.bid = b_; } while (0)
    { LAS unsigned long long* lp = (LAS unsigned long long*)(C.lds + ARG_OFF);
      if (C.tid == 0) {
#pragma unroll
          for (int i = 0; i < 21; ++i) lp[i] = (unsigned long long)A.in[i];
          lp[21] = (unsigned long long)A.out; lp[22] = (unsigned long long)A.ws;
          volatile LAS unsigned* st = (volatile LAS unsigned*)(C.lds + ARG_OFF + 512); st[0] = 0u; st[1] = 0u;
          if (A.ph_hi - A.ph_lo > 1) (void)xb_add((unsigned*)(A.ws + WS_BAR) + XB_XCNT(xb_xcc_id()), 1u); }
      __syncthreads(); }
    const int ph_lo = A.ph_lo, ph_hi = A.ph_hi;
    for (int ph = ph_lo; ph < ph_hi; ++ph) {
        REFRESH_CTX();
        if (ph > ph_lo) grid_barrier(C, (unsigned*)(ARGWS(C) + WS_BAR), (volatile LAS unsigned*)(C.lds + ARG_OFF + 512));
#ifndef PROBE_K
#define PROBE_K 100
#endif
        if (ph == 0) { if (PMASK & 512) { phase_prep(C); if (PROBE_K == 9) phase_prep(C); } continue; }
        const int l = (ph - 1) / 9, k = (ph - 1) % 9; const bool last = (l == 1);
        const int Mx = last ? NLAT : MROWS;
        unsigned char* ws = ARGWS(C);
        const float* modl = (const float*)(ws + WS_MOD) + (size_t)l * 5 * MODW;
        const bf16_t* wl = (const bf16_t*)(ws + WS_WT) + (size_t)l * WT_LAYER;
        float* xs = (float*)(ws + WS_XS); bf16_t* H = (bf16_t*)(ws + WS_H);
        pg8::StaticOrder S;
        for (int rep = 0; rep < ((k == PROBE_K) ? 2 : 1); ++rep) { REFRESH_CTX();
        switch (k) {
        case 0: if (PMASK & 1) if (l == 0) phase_norm(C, ARGP(C, 0), ARGP(C, 2), H, ARGP(C, 6), modl, 0, DM, MROWS, nullptr, 0, nullptr);
                else phase_norm(C, xs, xs + (size_t)NLAT * DM, H, ARGP(C, 6) + l * DM, modl, 0, DM, MROWS, (const float*)(ws + WS_PB), KSPLIT, xs);
                break;
        case 1: if (PMASK & 2) { pg8::Gemm g{H, wl + WT_IN, MROWS, PROJ, DM, 0, 0}; S.init(MROWS, PROJ, C.G, C.bid); pg8::EpiIn E{(bf16_t*)(ws + WS_Z), (bf16_t*)(ws + WS_G), ARGP(C, 9) + (size_t)l * GW};
                  pg8::gemm_phase<pg8::EpiIn, true>(C.lds, C.tid, g, S, E); } break;
        case 2: if (PMASK & 4) phase_qknorm(C, (bf16_t*)(ws + WS_Z), ARGP(C, 10) + l * 384, (const float*)(ws + WS_ROPE), (const float*)(ws + WS_ROPE) + SEQ * 32); break;
        case 3: if (PMASK & 8) phase_mixers(C, l, last); break;
        case 4: if (PMASK & 16) { pg8::Gemm g{(const bf16_t*)(ws + WS_Y), wl + WT_BR, Mx, DM, DM, 0, 0}; const bool coop = (ph_hi - ph_lo > 1);
                  if (last) S.init(NLAT, DM, C.G, C.bid); else if (coop) S.init(NLAT, DM, C.G, C.bid, NCTX, 4); else S.init(MROWS, DM, C.G, C.bid);
                  pg8::EpiMerge E{(const bf16_t*)(ws + WS_G), (bf16_t*)(ws + WS_MB), (float*)(ws + WS_PB)};
                  pg8::gemm_phase<pg8::EpiMerge, true>(C.lds, C.tid, g, S, E);
                  if (!last && coop) {
                      grid_barrier(C, (unsigned*)(ws + WS_BAR), (volatile LAS unsigned*)(C.lds + ARG_OFF + 512));
                      const GAS f32x4* pb = (const GAS f32x4*)(ws + WS_PB); GAS u32x2* mb = (GAS u32x2*)((bf16_t*)(ws + WS_MB) + (size_t)NLAT * DM);
                      constexpr int NQ = NCTX * DM / 4;
                      const int i0 = C.bid * NTHREADS + C.tid, st = C.G * NTHREADS;
                      for (int ib = i0; ib < NQ; ib += 4 * st) { f32x4 t[4][4];
#pragma unroll
                          for (int q = 0; q < 4; ++q) { const int i = min(ib + q * st, NQ - 1);
#pragma unroll
                              for (int k = 0; k < 4; ++k) t[q][k] = pb[k * NQ + i]; }
#pragma unroll
                          for (int q = 0; q < 4; ++q) { const int i = ib + q * st; const f32x4 v = (t[q][0] + t[q][1]) + (t[q][2] + t[q][3]);
                              u32x2 w; w.x = pk2(v[0], v[1]); w.y = pk2(v[2], v[3]); if (i < NQ) mb[i] = w; } } } } break;
        case 5: if (PMASK & 32) { pg8::Gemm g{(const bf16_t*)(ws + WS_MB), wl + WT_OUT, Mx, DM, DM, 0, 0}; if (last) S.init(NLAT, DM, C.G, C.bid); else S.init(NLAT, DM, C.G, C.bid, NCTX, KSPLIT);
                  pg8::EpiRes E{last ? xs : ARGP(C, 0), last ? xs + (size_t)NLAT * DM : ARGP(C, 2), xs, modl + 2 * DM, (float*)(ws + WS_PB)};
                  pg8::gemm_phase<pg8::EpiRes, true>(C.lds, C.tid, g, S, E); } break;
        case 6: if (PMASK & 64) if (last) phase_norm(C, xs, xs + (size_t)NLAT * DM, H, ARGP(C, 7) + l * DM, modl, 3 * DM, 4 * DM, Mx, nullptr, 0, nullptr);
                else phase_norm(C, xs, ARGP(C, 2), H, ARGP(C, 7), modl, 3 * DM, 4 * DM, Mx, (const float*)(ws + WS_PB), KSPLIT, xs);
                break;
        case 7: if (PMASK & 128) { pg8::Gemm g{H, wl + WT_F1, Mx, DFF, DM, 0, 0}; S.init(Mx, DFF, C.G, C.bid); pg8::EpiSq E{(bf16_t*)(ws + WS_U), DFF};
                  pg8::gemm_phase<pg8::EpiSq, true>(C.lds, C.tid, g, S, E); } break;
        case 8: if (PMASK & 256) { pg8::Gemm g{(const bf16_t*)(ws + WS_U), wl + WT_F2, Mx, DM, DFF, MROWS, DM};        if (last) S.init(NLAT, DM, C.G, C.bid); else S.init(NLAT, DM, C.G, C.bid, NCTX, KSPLIT);
                  pg8::EpiRes E{xs, xs + (size_t)NLAT * DM, last ? (float*)ARGP(C, 21) : xs, modl + 5 * DM, (float*)(ws + WS_PB)};
                  pg8::gemm_phase<pg8::EpiRes, true>(C.lds, C.tid, g, S, E); } break;
        } }
    }
}

extern "C" void kernel_launch(void* const* d_in, const int* in_sizes, int n_in, void* d_out, int out_size, void* d_ws, size_t ws_size, hipStream_t stream) {
    static int grid = 0;
    if (grid == 0) {
        if (n_in != 21 || out_size != NLAT * DM || ws_size < WS_END) { fprintf(stderr, "kernel_launch: unexpected shapes (n_in %d, out %d, ws %zu); nothing launched\n", n_in, out_size, ws_size); grid = -1; return; }
        int dev = 0, cus = 0, per_cu = 0;
        if (hipGetDevice(&dev) != hipSuccess || hipDeviceGetAttribute(&cus, hipDeviceAttributeMultiprocessorCount, dev) != hipSuccess) { grid = -1; return; }
        if (hipFuncSetAttribute((const void*)fwd_kernel, hipFuncAttributeMaxDynamicSharedMemorySize, LDS_BYTES) != hipSuccess) { fprintf(stderr, "kernel_launch: hipFuncSetAttribute failed\n"); grid = -1; return; }
        if (hipOccupancyMaxActiveBlocksPerMultiprocessor(&per_cu, (const void*)fwd_kernel, NTHREADS, LDS_BYTES) != hipSuccess || per_cu < 1) { fprintf(stderr, "kernel_launch: occupancy query says %d blocks per CU\n", per_cu); per_cu = 1; }
        (void)hipGetLastError();
        grid = cus * per_cu;
        if (grid > 256) grid = 256;
    }
    if (grid < 0) return;
    Args a{};
    for (int i = 0; i < 21; ++i) a.in[i] = (const float*)d_in[i];
    a.out = (float*)d_out; a.ws = (unsigned char*)d_ws;
#if N_LAUNCH_MODE == 1
    a.ph_lo = 0; a.ph_hi = N_PHASES;
    if (hipMemsetAsync((char*)d_ws + WS_BAR, 0, 16384, stream) != hipSuccess) { fprintf(stderr, "kernel_launch: memset failed\n"); return; }
    void* args[] = {&a};
    hipError_t e = hipLaunchCooperativeKernel((const void*)fwd_kernel, dim3(grid), dim3(NTHREADS), args, LDS_BYTES, stream);
    if (e != hipSuccess) fprintf(stderr, "cooperative launch failed: %s (grid %d)\n", hipGetErrorString(e), grid);
#else
    for (int ph = 0; ph < N_PHASES; ++ph) { a.ph_lo = ph; a.ph_hi = ph + 1; hipLaunchKernelGGL(fwd_kernel, dim3(grid), dim3(NTHREADS), LDS_BYTES, stream, a); }
#endif
}
```
